# Optimizing an MI355X kernel written in HIP

```python
import jax, jax.numpy as jnp
from jax import lax
import numpy as np

D_MODEL = 2048
BATCH = 16
SEQ = 2048
DEPTH = 1
DEC_BATCH = 32
DEC_SEQ = 32
PAST_LEN = 2048

CHUNK = 64
N_META = 16
MIX_WIDTH = D_MODEL
POOL_WIDTH = MIX_WIDTH // 2
CONV_WIDTH = MIX_WIDTH - POOL_WIDTH
POOL_WINDOWS = (2, 4, 8, 16)
POOL_GROUPS = len(POOL_WINDOWS)
POOL_GC = POOL_WIDTH // POOL_GROUPS
POOL_HIST = max(POOL_WINDOWS) - 1
CONV_HEADS = 8
CONV_K = 3
CONV_HIST = CONV_K - 1
IN_WIDTH = POOL_WIDTH + 3 * CONV_WIDTH
D_FF = 4 * D_MODEL
EPS = 1e-6

kernel_name = "hymba_pool_shortconv_stream_step"


def _rmsnorm(x, g):
    xf = x.astype(jnp.float32)
    r = lax.rsqrt(jnp.mean(xf * xf, axis=-1, keepdims=True) + EPS)
    return (xf * r * g.astype(jnp.float32)).astype(x.dtype)


def _pool_mixer(u, hist, hist_valid, w_pool, scale):
    B, L, C = u.shape
    ext = jnp.concatenate([hist.astype(u.dtype), u], axis=1)
    extf = ext.astype(jnp.float32)
    cs = jnp.concatenate([jnp.zeros((B, 1, C), jnp.float32), jnp.cumsum(extf, axis=1)], axis=1)
    valid = jnp.concatenate([jnp.full((POOL_HIST,), hist_valid, jnp.float32), jnp.ones((L,), jnp.float32)])
    cv = jnp.concatenate([jnp.zeros((1,), jnp.float32), jnp.cumsum(valid)])
    H1 = POOL_HIST + 1
    parts = []
    for g, w in enumerate(POOL_WINDOWS):
        sl = slice(g * POOL_GC, (g + 1) * POOL_GC)
        s = cs[:, H1:H1 + L, sl] - cs[:, H1 - w:H1 - w + L, sl]
        n = cv[H1:H1 + L] - cv[H1 - w:H1 - w + L]
        parts.append(s / n[None, :, None])
    mean = jnp.concatenate(parts, axis=-1)
    d = (mean - u.astype(jnp.float32)).astype(u.dtype).reshape(B, L, POOL_GROUPS, POOL_GC)
    y = jnp.einsum('blgc,gcd->blgd', d, w_pool).reshape(B, L, C) * scale
    return y, ext[:, -POOL_HIST:]


def _short_conv_mixer(bg, cg, v, hist, conv_w):
    z = cg * v
    L = z.shape[1]
    ext = jnp.concatenate([hist.astype(z.dtype), z], axis=1)
    out = ext[:, 0:L] * conv_w[0]
    for k in range(1, CONV_K):
        out = out + ext[:, k:k + L] * conv_w[k]
    return bg * out, ext[:, -CONV_HIST:]


def _layer(x, pool_hist, conv_hist, hist_valid, norm1_g, w_in, w_pool, pool_scale,
           conv_w, w_out, norm2_g, w_up, w_down):
    hn = _rmsnorm(x, norm1_g)
    proj = jnp.einsum('bld,de->ble', hn, w_in)
    u = proj[..., :POOL_WIDTH]
    bg = proj[..., POOL_WIDTH:POOL_WIDTH + CONV_WIDTH]
    cg = proj[..., POOL_WIDTH + CONV_WIDTH:POOL_WIDTH + 2 * CONV_WIDTH]
    v = proj[..., POOL_WIDTH + 2 * CONV_WIDTH:]
    y_pool, new_pool = _pool_mixer(u, pool_hist, hist_valid, w_pool, pool_scale)
    y_conv, new_conv = _short_conv_mixer(bg, cg, v, conv_hist, conv_w)
    mix = jnp.concatenate([y_pool, y_conv], axis=-1)
    x = x + jnp.einsum('ble,ed->bld', mix, w_out)
    hn2 = _rmsnorm(x, norm2_g)
    a = jax.nn.relu(jnp.einsum('bld,df->blf', hn2, w_up))
    x = x + jnp.einsum('blf,fd->bld', a * a, w_down)
    return x, new_pool, new_conv


def setup_inputs(seed: int = 0) -> dict:
    key = jax.random.key(seed)
    ks = jax.random.split(key, 16)
    f32 = jnp.float32
    x_prompt = jax.random.normal(ks[0], (BATCH, SEQ, D_MODEL), f32)
    x_sample = jax.random.normal(ks[1], (DEC_BATCH, DEC_SEQ, D_MODEL), f32)
    cache_pool = jax.random.normal(ks[2], (DEPTH, DEC_BATCH, POOL_HIST, POOL_WIDTH), f32)
    cache_conv = jax.random.normal(ks[3], (DEPTH, DEC_BATCH, CONV_HIST, CONV_WIDTH), f32)
    meta_tokens = jax.random.normal(ks[4], (N_META, D_MODEL), f32)
    norm1_g = 1.0 + 0.05 * jax.random.normal(ks[5], (DEPTH, D_MODEL), f32)
    w_in = jax.random.normal(ks[6], (DEPTH, D_MODEL, IN_WIDTH), f32) * D_MODEL ** -0.5
    w_pool = jax.random.normal(ks[7], (DEPTH, POOL_GROUPS, POOL_GC, POOL_GC), f32) * POOL_GC ** -0.5
    pool_scale = 1.0 + 0.1 * jax.random.normal(ks[8], (DEPTH, POOL_WIDTH), f32)
    conv_w = jax.random.normal(ks[9], (DEPTH, CONV_K, CONV_WIDTH), f32) * CONV_K ** -0.5
    w_out = jax.random.normal(ks[10], (DEPTH, MIX_WIDTH, D_MODEL), f32) * MIX_WIDTH ** -0.5
    norm2_g = 1.0 + 0.05 * jax.random.normal(ks[11], (DEPTH, D_MODEL), f32)
    w_up = jax.random.normal(ks[12], (DEPTH, D_MODEL, D_FF), f32) * D_MODEL ** -0.5
    w_down = jax.random.normal(ks[13], (DEPTH, D_FF, D_MODEL), f32) * D_FF ** -0.5
    final_g = 1.0 + 0.05 * jax.random.normal(ks[14], (D_MODEL,), f32)
    return {"x_prompt": x_prompt, "x_sample": x_sample, "cache_pool": cache_pool,
            "cache_conv": cache_conv, "meta_tokens": meta_tokens, "norm1_g": norm1_g,
            "w_in": w_in, "w_pool": w_pool, "pool_scale": pool_scale, "conv_w": conv_w,
            "w_out": w_out, "norm2_g": norm2_g, "w_up": w_up, "w_down": w_down,
            "final_g": final_g}


def reference(x_prompt, x_sample, cache_pool, cache_conv, meta_tokens, norm1_g, w_in, w_pool,
              pool_scale, conv_w, w_out, norm2_g, w_up, w_down, final_g):
    bp = x_prompt.shape[0]
    meta = jnp.broadcast_to(meta_tokens.astype(x_prompt.dtype)[None], (bp, N_META, x_prompt.shape[-1]))
    hp = jnp.concatenate([meta, x_prompt], axis=1)
    hs = x_sample
    zp_pool = jnp.zeros((bp, POOL_HIST, POOL_WIDTH), x_prompt.dtype)
    zp_conv = jnp.zeros((bp, CONV_HIST, CONV_WIDTH), x_prompt.dtype)
    sp_pool, sp_conv, ss_pool, ss_conv = [], [], [], []
    for l in range(DEPTH):
        hp, p_pool, p_conv = _layer(hp, zp_pool, zp_conv, 0.0, norm1_g[l], w_in[l], w_pool[l],
                                    pool_scale[l], conv_w[l], w_out[l], norm2_g[l], w_up[l], w_down[l])
        hs, s_pool, s_conv = _layer(hs, cache_pool[l], cache_conv[l], 1.0, norm1_g[l], w_in[l], w_pool[l],
                                    pool_scale[l], conv_w[l], w_out[l], norm2_g[l], w_up[l], w_down[l])
        sp_pool.append(p_pool)
        sp_conv.append(p_conv)
        ss_pool.append(s_pool)
        ss_conv.append(s_conv)
    y_prompt = _rmsnorm(hp, final_g)[:, N_META:]
    y_sample = _rmsnorm(hs, final_g)
    state_pool_prompt = jnp.stack(sp_pool, axis=0)
    state_conv_prompt = jnp.stack(sp_conv, axis=0)
    state_pool_sample = jnp.stack(ss_pool, axis=0)
    state_conv_sample = jnp.stack(ss_conv, axis=0)
    return (y_prompt, y_sample, state_pool_prompt, state_conv_prompt, state_pool_sample, state_conv_sample)
```

```cpp
#include <hip/hip_runtime.h>
#include <hip/hip_cooperative_groups.h>
#include <cstdio>
#include <cstdint>
namespace cg = cooperative_groups;

constexpr int D = 2048, NB = 16, SEQ = 2048, NMETA = 16, LP = SEQ + NMETA, SB = 32, SL = 32;
constexpr int MP = NB * LP;
constexpr int MS = SB * SL;
constexpr int M1 = MP + MS;
constexpr int MPO = NB * SEQ;
constexpr int M2 = MPO + MS;
constexpr int INW = 4096, PW = 1024, CW = 1024, FF = 8192, PGC = 256;
constexpr int LDP = INW;
#define ZOFF(ch) (2 * PW + 128 * ((ch) >> 7))
constexpr float EPS = 1e-6f;
static_assert(M1 % 256 == 0 && M2 % 256 == 0, "row tiles");

constexpr size_t MiB = 1u << 20;
constexpr size_t WS_CTL = 0;
constexpr size_t WS_WIN = 1 * MiB;
constexpr size_t WS_WOUT = 17 * MiB;
constexpr size_t WS_WUP = 25 * MiB;
constexpr size_t WS_WDOWN = 57 * MiB;
constexpr size_t WS_WPOOL = 89 * MiB;
constexpr size_t WS_SSQ = 90 * MiB;
constexpr size_t WS_HN = 91 * MiB;
constexpr size_t WS_BIG = 224 * MiB;
constexpr size_t WS_PROJ = WS_BIG;
constexpr size_t WS_DMAT = WS_BIG + 266 * MiB;
constexpr size_t WS_MIX = WS_BIG + 528 * MiB;
constexpr size_t WS_END = WS_MIX + 132 * MiB;
static_assert(WS_HN + (size_t)M1 * D * 2 <= WS_BIG && WS_PROJ + (size_t)M1 * LDP * 2 <= WS_DMAT && WS_MIX + (size_t)M2 * D * 2 <= WS_END && (size_t)M2 * FF * 2 <= 528 * MiB && WS_DMAT + (size_t)M2 * PW * 2 <= WS_BIG + 528 * MiB, "ws map");

constexpr size_t O_Y = 0;
constexpr size_t O_SPP = (size_t)M2 * D;
constexpr size_t O_SCP = O_SPP + (size_t)NB * 15 * PW;
constexpr size_t O_SPS = O_SCP + (size_t)NB * 2 * CW;
constexpr size_t O_SCS = O_SPS + (size_t)SB * 15 * PW;

#ifndef WGM_A
#define WGM_A 4
#endif
#ifndef WGM_B
#define WGM_B 4
#endif
constexpr int LDS_BYTES = 135168;

namespace pg8 {
#define PG8_LAS __attribute__((address_space(3)))
typedef unsigned short bf16_t;
typedef short bf16x8 __attribute__((ext_vector_type(8)));
typedef float f32x4 __attribute__((ext_vector_type(4)));
typedef unsigned u32x4 __attribute__((ext_vector_type(4)));
constexpr int BM = 256, BK = 64, HALF = 128, HTB = HALF * BK * 2, STAGE_BYTES = 8 * HTB, NXCD = 8;

__host__ __device__ __forceinline__ int lds_byte(int r, int c) { const int st = (r >> 4) * 2 + (c >> 5), rr = r & 15, cc = c & 31, ob = rr * 64 + cc * 2; return st * 1024 + (ob ^ (((ob >> 9) & 1) << 5)); }
__host__ __device__ __forceinline__ void stage_rc(int b, int& R, int& C) { const int st = b / 1024, sb = b % 1024, swz = sb ^ (((sb >> 9) & 1) << 5); R = (st >> 1) * 16 + swz / 64; C = (st & 1) * 32 + (swz % 64) / 2; }
__host__ __device__ __forceinline__ int perm32(int rho) { const int n = rho >> 4, i = rho & 15; return 8 * (i >> 2) + 4 * n + (i & 3); }

struct Unit { int pm, pn, boff1; };
struct Gemm { const bf16_t* A; const bf16_t* Bt; int M, N, K, lda, ldb, apn; };

struct StaticOrder {
    int nM, nN, nwg, G, c, tail_round, ntail, sig_ui, WGM, round0; unsigned* sig; unsigned nloc;
    __host__ __device__ void init(int M, int N, int G_, int c_, int wgm, int tail_panels = 0, unsigned* sig_ = nullptr, int sig_ui_ = -1, unsigned nloc_ = 0, int round0_ = 0) {
        WGM = wgm; round0 = round0_;
        nM = M / BM; nN = N / BM; nwg = nM * nN; G = G_; c = c_; tail_round = tail_panels ? nwg / G : -1; ntail = tail_panels * nN; sig = sig_; sig_ui = sig_ui_; nloc = nloc_; }
    __host__ __device__ bool next(int i_, Unit& u) const {
        const int i = i_ + round0; const bool tl = (i == tail_round);
        const long L = (long)i * G + c; const bool ok = tl ? (c < ntail) : (L < nwg);
        int wgid = (int)(L < nwg ? L : 0); { const int q = nwg / NXCD, r = nwg % NXCD, xcd = wgid % NXCD, off = wgid / NXCD; wgid = (xcd < r ? xcd * (q + 1) : r * (q + 1) + (xcd - r) * q) + off; }
        const int nig = WGM * nN, gid = wgid / nig, fm = gid * WGM, gsz = (nM - fm) < WGM ? (nM - fm) : WGM;
        const int pm = fm + ((wgid % nig) % gsz), pn = (wgid % nig) / gsz;
        u.pm = tl ? nM + c / nN : pm; u.pn = tl ? c % nN : pn;
        return ok;
    }
    __device__ __forceinline__ void a_ready(const Unit&) const {}
    __device__ __forceinline__ void done(const Unit&, int ui) const {
        if (sig != nullptr && ui == sig_ui) {
            asm volatile("s_waitcnt vmcnt(0)" ::: "memory");
            __builtin_amdgcn_s_barrier();
            if (threadIdx.x == 0) {
                const unsigned x = (unsigned)__builtin_amdgcn_s_getreg((3 << 11) | 20) & 0xFu;
                const unsigned old = __hip_atomic_fetch_add(sig + 64 * (1 + x), 1u, __ATOMIC_RELAXED, __HIP_MEMORY_SCOPE_AGENT);
                if (old + 1u == nloc) {
                    __builtin_amdgcn_fence(__ATOMIC_RELEASE, "agent");
                    asm volatile("s_waitcnt vmcnt(0)" ::: "memory");
                    __hip_atomic_fetch_add(sig, 1u, __ATOMIC_RELAXED, __HIP_MEMORY_SCOPE_AGENT);
                }
            }
        }
    }
};

__device__ __forceinline__ unsigned cvt_pk_bf16(float lo, float hi) { unsigned r; asm volatile("v_cvt_pk_bf16_f32 %0, %1, %2" : "=v"(r) : "v"(lo), "v"(hi)); return r; }

struct EpiAny {
    static constexpr bool AFTER_DRAIN = false;
    int mode; bf16_t* O; int ldc; const float* scale; const float* xp; const float* xs; float* out; float* ssq; int zpn0;
    __device__ __forceinline__ bool perm() const { return true; }
    __device__ __forceinline__ void operator()(const f32x4 (&acc)[2][2][4][2], const Unit& u, int wr, int wc, int fr, int fq) const {
        const int row0 = u.pm * BM + wr * 64 + fr, col0 = u.pn * BM + wc * 32 + 8 * fq;
        if (mode == 4) {
            float ss[2][4];
#pragma unroll
            for (int ai = 0; ai < 2; ++ai)
#pragma unroll
                for (int m = 0; m < 4; ++m) ss[ai][m] = 0.f;
#pragma unroll
            for (int bj = 0; bj < 2; ++bj) {
#pragma unroll
                for (int ai = 0; ai < 2; ++ai)
#pragma unroll
                    for (int m = 0; m < 4; ++m) { const int row = row0 + ai * HALF + m * 16;
                        const float* xr = (row < MPO ? xp + (size_t)row * D : xs + (size_t)(row - MPO) * D) + col0 + bj * HALF;
                        const f32x4 h0 = __builtin_nontemporal_load((const f32x4*)xr) + acc[ai][bj][m][0], h1 = __builtin_nontemporal_load((const f32x4*)(xr + 4)) + acc[ai][bj][m][1];
                        ss[ai][m] += ((h0[0] * h0[0] + h0[1] * h0[1]) + (h0[2] * h0[2] + h0[3] * h0[3])) + ((h1[0] * h1[0] + h1[1] * h1[1]) + (h1[2] * h1[2] + h1[3] * h1[3]));
                        u32x4 w; w.x = cvt_pk_bf16(h0[0], h0[1]); w.y = cvt_pk_bf16(h0[2], h0[3]); w.z = cvt_pk_bf16(h1[0], h1[1]); w.w = cvt_pk_bf16(h1[2], h1[3]);
                        *(u32x4*)(O + (size_t)row * ldc + col0 + bj * HALF) = w;
                        if (m & 1) asm volatile("" ::: "memory"); }
            }
#pragma unroll
            for (int ai = 0; ai < 2; ++ai)
#pragma unroll
                for (int m = 0; m < 4; ++m) { float sr = ss[ai][m]; sr += __shfl_xor(sr, 16); sr += __shfl_xor(sr, 32);
                    if (fq == 0) __hip_atomic_fetch_add(ssq + row0 + ai * HALF + m * 16, sr, __ATOMIC_RELAXED, __HIP_MEMORY_SCOPE_AGENT); }
        } else if (mode == 5) {
            float ri[2][4];
#pragma unroll
            for (int ai = 0; ai < 2; ++ai)
#pragma unroll
                for (int m = 0; m < 4; ++m) ri[ai][m] = 1.f / (ssq[row0 + ai * HALF + m * 16] * (1.f / D) + EPS);
#pragma unroll
            for (int bj = 0; bj < 2; ++bj)
#pragma unroll
                for (int ai = 0; ai < 2; ++ai)
#pragma unroll
                    for (int m = 0; m < 4; ++m) { const int row = row0 + ai * HALF + m * 16; const u32x4 hb = *(const u32x4*)(O + (size_t)row * ldc + col0 + bj * HALF);
                        const f32x4 r0 = (f32x4){__uint_as_float(hb.x << 16), __uint_as_float(hb.x & 0xffff0000u), __uint_as_float(hb.y << 16), __uint_as_float(hb.y & 0xffff0000u)};
                        const f32x4 r1 = (f32x4){__uint_as_float(hb.z << 16), __uint_as_float(hb.z & 0xffff0000u), __uint_as_float(hb.w << 16), __uint_as_float(hb.w & 0xffff0000u)};
                        const f32x4 v0 = r0 + acc[ai][bj][m][0] * ri[ai][m], v1 = r1 + acc[ai][bj][m][1] * ri[ai][m];
                        u32x4 w; w.x = cvt_pk_bf16(v0[0], v0[1]); w.y = cvt_pk_bf16(v0[2], v0[3]); w.z = cvt_pk_bf16(v1[0], v1[1]); w.w = cvt_pk_bf16(v1[2], v1[3]);
                        __builtin_nontemporal_store(w, (u32x4*)(O + (size_t)row * ldc + col0 + bj * HALF));
                        if (m & 1) asm volatile("" ::: "memory"); }
        } else {
            const int boff1 = u.boff1;
#pragma unroll
            for (int bj = 0; bj < 2; ++bj) {
                f32x4 sv0 = (f32x4){1.f, 1.f, 1.f, 1.f}, sv1 = sv0;
                if (mode == 2) { sv0 = *(const f32x4*)(scale + col0 + bj * HALF); sv1 = *(const f32x4*)(scale + col0 + bj * HALF + 4); }
#pragma unroll
                for (int ai = 0; ai < 2; ++ai)
#pragma unroll
                    for (int m = 0; m < 4; ++m) { bf16_t* rowp = O + (size_t)(row0 + ai * HALF + m * 16) * ldc + col0;
                        f32x4 v0 = acc[ai][bj][m][0], v1 = acc[ai][bj][m][1];
                        if (mode == 1) {
#pragma unroll
                            for (int j = 0; j < 4; ++j) { const float a = fmaxf(v0[j], 0.f), b = fmaxf(v1[j], 0.f); v0[j] = a * a; v1[j] = b * b; } }
                        if (mode == 2) { v0 = v0 * sv0; v1 = v1 * sv1; }
                        u32x4 w; w.x = cvt_pk_bf16(v0[0], v0[1]); w.y = cvt_pk_bf16(v0[2], v0[3]); w.z = cvt_pk_bf16(v1[0], v1[1]); w.w = cvt_pk_bf16(v1[2], v1[3]);
                        if (bj == 0 || boff1 != 0) __builtin_nontemporal_store(w, (u32x4*)(rowp + bj * HALF)); }
            }
        }
    }
};

template <class Epi, class Sched, bool ALIGN_EPI = false, bool SP2 = false>
__device__ __forceinline__ void gemm_phase(PG8_LAS unsigned char* lds, const Gemm g, const Sched& S, const Epi& E) {
    int tid_ = threadIdx.x; asm volatile("" : "+v"(tid_));
    const int tid = tid_, wid = __builtin_amdgcn_readfirstlane(tid >> 6), lane = tid & 63, wr = wid >> 2, wc = wid & 3, fr = lane & 15, fq = lane >> 4;
    const int K = g.K, nt = K / BK;
    unsigned voffA[2], voffB[2];
#pragma unroll
    for (int i = 0; i < 2; ++i) { int R, C; stage_rc(tid * 16 + i * 8192, R, C); const int Rb = E.perm() ? ((R & ~31) + perm32(R & 31)) : R;
        voffA[i] = (unsigned)(R * g.lda + C) * 2u; voffB[i] = (unsigned)(Rb * g.ldb + C) * 2u; }
    const size_t kstep = (size_t)(BK * 2);
    const size_t hstepA = (size_t)HALF * g.lda * 2, hstepB = (size_t)HALF * g.ldb * 2;
    const size_t tstepA = 2 * hstepA, tstepB = 2 * hstepB;
    const size_t apn = (size_t)g.apn * 2;
    const unsigned ldsw = (unsigned)wid * 1024u;
    const int aoff = lds_byte(wr * 64 + fr, fq * 8), boff = lds_byte(wc * 32 + fr, fq * 8);
#define PG8_SA(b, h) (((b) * 2 + (h)) * HTB)
#define PG8_SB(b, h) ((4 + (b) * 2 + (h)) * HTB)
#define PG8_STAGE(bufoff, gbase, voff) do { _Pragma("unroll") for (int _i = 0; _i < 2; ++_i) \
        __builtin_amdgcn_global_load_lds((const unsigned*)((const char*)(gbase) + (voff)[_i]), (PG8_LAS unsigned*)(lds + (bufoff) + ldsw + _i * 8192), 16, 0, 0); } while (0)
#define PG8_LDA(dst, b, h) do { _Pragma("unroll") for (int m = 0; m < 4; ++m) _Pragma("unroll") for (int k = 0; k < 2; ++k) dst[m][k] = *(const PG8_LAS bf16x8*)(lds + PG8_SA(b, h) + aoff + m * 2048 + k * 1024); } while (0)
#define PG8_LDB(dst, b, h) do { _Pragma("unroll") for (int n = 0; n < 2; ++n) _Pragma("unroll") for (int k = 0; k < 2; ++k) dst[n][k] = *(const PG8_LAS bf16x8*)(lds + PG8_SB(b, h) + boff + n * 2048 + k * 1024); } while (0)
#define PG8_MMA(ai, bj, At, Bt) do { __builtin_amdgcn_s_setprio(2); _Pragma("unroll") for (int m = 0; m < 4; ++m) _Pragma("unroll") for (int n = 0; n < 2; ++n) _Pragma("unroll") for (int k = 0; k < 2; ++k) \
        acc[ai][bj][m][n] = __builtin_amdgcn_mfma_f32_16x16x32_bf16(Bt[n][k], At[m][k], acc[ai][bj][m][n], 0, 0, 0); __builtin_amdgcn_s_setprio(0); } while (0)
#define PG8_WAIT_V(n) asm volatile("s_waitcnt vmcnt(" #n ")" ::: "memory")
#define PG8_WAIT_L(n) asm volatile("s_waitcnt lgkmcnt(" #n ")" ::: "memory")
#define PG8_BAR __builtin_amdgcn_s_barrier()
#define PG8_SCHED __builtin_amdgcn_sched_barrier(0)
    Unit cur, nxt; int ui = 0;
    if (!S.next(0, cur)) return;
    f32x4 acc[2][2][4][2];
#pragma unroll
    for (int a = 0; a < 2; ++a)
#pragma unroll
        for (int b = 0; b < 2; ++b)
#pragma unroll
            for (int m = 0; m < 4; ++m)
#pragma unroll
                for (int n = 0; n < 2; ++n) acc[a][b][m][n] = (f32x4){0.f, 0.f, 0.f, 0.f};
    bf16x8 At[4][2], B0[2][2], B1[2][2];
    const char* cA = (const char*)g.A + (size_t)cur.pm * tstepA + (size_t)cur.pn * apn; const char* cB = (const char*)g.Bt + (size_t)cur.pn * tstepB;
    S.a_ready(cur);
    if constexpr (SP2) {
        PG8_STAGE(PG8_SB(0, 0), cB, voffB); PG8_STAGE(PG8_SB(0, 1), cB + hstepB, voffB); PG8_STAGE(PG8_SA(0, 0), cA, voffA); PG8_STAGE(PG8_SA(0, 1), cA + hstepA, voffA);
        if (wr == 1) PG8_BAR;
        PG8_WAIT_V(2); PG8_BAR;
        PG8_STAGE(PG8_SB(1, 0), cB + kstep, voffB); PG8_STAGE(PG8_SA(1, 0), cA + kstep, voffA); PG8_STAGE(PG8_SB(1, 1), cB + hstepB + kstep, voffB);
        PG8_WAIT_V(6); PG8_BAR;
    } else {
        PG8_STAGE(PG8_SB(0, 0), cB, voffB); PG8_STAGE(PG8_SA(0, 0), cA, voffA); PG8_STAGE(PG8_SB(0, 1), cB + hstepB, voffB); PG8_STAGE(PG8_SA(0, 1), cA + hstepA, voffA);
        if (wr == 1) PG8_BAR;
        PG8_WAIT_V(4); PG8_BAR;
        PG8_STAGE(PG8_SB(1, 0), cB + kstep, voffB); PG8_STAGE(PG8_SA(1, 0), cA + kstep, voffA); PG8_STAGE(PG8_SB(1, 1), cB + hstepB + kstep, voffB);
        PG8_WAIT_V(6); PG8_BAR;
    }
    for (;;) {
        const bool has_next = S.next(ui + 1, nxt);
        const char* nA = has_next ? (const char*)g.A + (size_t)nxt.pm * tstepA + (size_t)nxt.pn * apn : cA; const char* nB = has_next ? (const char*)g.Bt + (size_t)nxt.pn * tstepB : cB;
        for (int t = 0; t < nt; t += 2) {
            const bool last = (t == nt - 2);
            const char* a1 = cA + (size_t)(t + 1) * kstep;
            const char* a2 = last ? nA : cA + (size_t)(t + 2) * kstep; const char* b2 = last ? nB : cB + (size_t)(t + 2) * kstep;
            const char* a3 = a2 + kstep; const char* b3 = b2 + kstep;
            if (last && has_next) S.a_ready(nxt);
            if constexpr (SP2) {
            PG8_LDB(B0, 0, 0); PG8_LDB(B1, 0, 1); PG8_SCHED; PG8_LDA(At, 0, 0); PG8_STAGE(PG8_SA(1, 1), a1 + hstepA, voffA);
            PG8_WAIT_V(8); PG8_WAIT_L(0); PG8_BAR; PG8_MMA(0, 0, At, B0); PG8_MMA(0, 1, At, B1); PG8_BAR; PG8_SCHED;
            PG8_LDA(At, 0, 1); PG8_STAGE(PG8_SB(0, 0), b2, voffB); PG8_STAGE(PG8_SB(0, 1), b2 + hstepB, voffB); PG8_STAGE(PG8_SA(0, 0), a2, voffA);
            PG8_WAIT_V(8); PG8_WAIT_L(0); PG8_BAR; PG8_MMA(1, 0, At, B0); PG8_MMA(1, 1, At, B1); PG8_BAR; PG8_SCHED;
            PG8_LDB(B0, 1, 0); PG8_LDB(B1, 1, 1); PG8_SCHED; PG8_LDA(At, 1, 0); PG8_STAGE(PG8_SA(0, 1), a2 + hstepA, voffA);
            PG8_WAIT_V(8); PG8_WAIT_L(0); PG8_BAR; PG8_MMA(0, 0, At, B0); PG8_MMA(0, 1, At, B1); PG8_BAR; PG8_SCHED;
            PG8_LDA(At, 1, 1); PG8_STAGE(PG8_SB(1, 0), b3, voffB); PG8_STAGE(PG8_SB(1, 1), b3 + hstepB, voffB); PG8_STAGE(PG8_SA(1, 0), a3, voffA);
            PG8_WAIT_V(8); PG8_WAIT_L(0); PG8_BAR; PG8_MMA(1, 0, At, B0); PG8_MMA(1, 1, At, B1); PG8_BAR; PG8_SCHED;
            } else {
            PG8_LDB(B0, 0, 0); PG8_SCHED; PG8_LDA(At, 0, 0); PG8_STAGE(PG8_SA(1, 1), a1 + hstepA, voffA);
            PG8_WAIT_L(8); PG8_BAR; PG8_WAIT_L(0); PG8_MMA(0, 0, At, B0); PG8_BAR; PG8_SCHED;
            PG8_LDB(B1, 0, 1); PG8_STAGE(PG8_SB(0, 0), b2, voffB);
            PG8_BAR; PG8_WAIT_L(0); PG8_MMA(0, 1, At, B1); PG8_BAR;
            PG8_LDA(At, 0, 1); PG8_STAGE(PG8_SA(0, 0), a2, voffA);
            PG8_BAR; PG8_WAIT_L(0); PG8_MMA(1, 0, At, B0); PG8_BAR; PG8_SCHED;
            PG8_STAGE(PG8_SB(0, 1), b2 + hstepB, voffB);
            PG8_WAIT_V(6); PG8_BAR; PG8_MMA(1, 1, At, B1); PG8_BAR;
            PG8_LDB(B0, 1, 0); PG8_SCHED; PG8_LDA(At, 1, 0); PG8_STAGE(PG8_SA(0, 1), a2 + hstepA, voffA);
            PG8_WAIT_L(8); PG8_BAR; PG8_WAIT_L(0); PG8_MMA(0, 0, At, B0); PG8_BAR; PG8_SCHED;
            PG8_LDB(B1, 1, 1); PG8_STAGE(PG8_SB(1, 0), b3, voffB);
            PG8_BAR; PG8_WAIT_L(0); PG8_MMA(0, 1, At, B1); PG8_BAR;
            PG8_LDA(At, 1, 1); PG8_STAGE(PG8_SA(1, 0), a3, voffA);
            PG8_BAR; PG8_WAIT_L(0); PG8_MMA(1, 0, At, B0); PG8_BAR; PG8_SCHED;
            PG8_STAGE(PG8_SB(1, 1), b3 + hstepB, voffB);
            PG8_WAIT_V(6); PG8_BAR; PG8_MMA(1, 1, At, B1); PG8_BAR;
            }
        }
        if constexpr (ALIGN_EPI) { if (wr == 0) PG8_BAR; }
        cur.boff1 = HALF;
        if (E.mode == 0 && cur.pn >= E.zpn0) {
            cur.boff1 = 0;
#pragma unroll
            for (int a = 0; a < 2; ++a)
#pragma unroll
                for (int m = 0; m < 4; ++m)
#pragma unroll
                    for (int n = 0; n < 2; ++n) { acc[a][0][m][n] = acc[a][0][m][n] * acc[a][1][m][n]; }
        }
        if constexpr (!Epi::AFTER_DRAIN) { E(acc, cur, wr, wc, fr, fq); S.done(cur, ui); }
        if (!has_next) break;
#pragma unroll
        for (int a = 0; a < 2; ++a)
#pragma unroll
            for (int b = 0; b < 2; ++b)
#pragma unroll
                for (int m = 0; m < 4; ++m)
#pragma unroll
                    for (int n = 0; n < 2; ++n) acc[a][b][m][n] = (f32x4){0.f, 0.f, 0.f, 0.f};
        cur = nxt; cA = nA; cB = nB; ++ui;
        if constexpr (ALIGN_EPI) { if (wr == 1) PG8_BAR; }
    }
    PG8_WAIT_V(0);
    if constexpr (!ALIGN_EPI) { if (wr == 0) PG8_BAR; }
    PG8_BAR;
#undef PG8_SA
#undef PG8_SB
#undef PG8_STAGE
#undef PG8_LDA
#undef PG8_LDB
#undef PG8_MMA
#undef PG8_WAIT_V
#undef PG8_WAIT_L
#undef PG8_BAR
#undef PG8_SCHED
}
}

#ifndef PG8_SP2
#define PG8_SP2 true
#endif
#ifndef PG8_ALIGN
#define PG8_ALIGN true
#endif

#define LAS __attribute__((address_space(3)))
typedef unsigned short bf16;
typedef unsigned v4u __attribute__((ext_vector_type(4)));
typedef unsigned v2u __attribute__((ext_vector_type(2)));
typedef float f32x4 __attribute__((ext_vector_type(4)));
#define LDS_WAIT() asm volatile("s_waitcnt lgkmcnt(0)" ::: "memory")
__device__ __forceinline__ unsigned pk2(float lo, float hi) { return pg8::cvt_pk_bf16(lo, hi); }
__device__ __forceinline__ float wave_sum(float v) {
#pragma unroll
    for (int o = 1; o < 64; o <<= 1) v += __shfl_xor(v, o);
    return v;
}
struct F8 { f32x4 a, b; };
__device__ __forceinline__ float bflo(unsigned u) { return __uint_as_float(u << 16); }
__device__ __forceinline__ float bfhi(unsigned u) { return __uint_as_float(u & 0xffff0000u); }
__device__ __forceinline__ F8 ld_bf8(const bf16* p) { const v4u w = *(const v4u*)p; F8 r; r.a = (f32x4){bflo(w.x), bfhi(w.x), bflo(w.y), bfhi(w.y)}; r.b = (f32x4){bflo(w.z), bfhi(w.z), bflo(w.w), bfhi(w.w)}; return r; }
__device__ __forceinline__ F8 ld_f8(const float* p) { F8 r; r.a = *(const f32x4*)p; r.b = *(const f32x4*)(p + 4); return r; }
__device__ __forceinline__ void st_bf8(bf16* p, const F8& v) { v4u w; w.x = pk2(v.a.x, v.a.y); w.y = pk2(v.a.z, v.a.w); w.z = pk2(v.b.x, v.b.y); w.w = pk2(v.b.z, v.b.w); *(v4u*)p = w; }
__device__ __forceinline__ void st_f8(float* p, const F8& v) { *(f32x4*)p = v.a; *(f32x4*)(p + 4) = v.b; }

__device__ __forceinline__ void p0_transpose_item(const float* W, int K, int N, bf16* WT, int row_off, LAS float* scr, int item, int lane, bool zperm = false, const float* kscale = nullptr, const float* nscale = nullptr) {
    const int nblk = N / 32, kb = item / nblk, nb = item % nblk, k0 = 64 * kb, n0 = 32 * nb;
    const int ns = (zperm && n0 >= 2 * PW) ? ((((n0 & 255) < 128) ? 2 * PW : 2 * PW + CW - 128) + 128 * ((n0 >> 8) - 8) + (n0 & 255)) : n0;
    const int l7 = lane & 7, l8 = lane >> 3;
    f32x4 v[8];
#pragma unroll
    for (int i = 0; i < 8; ++i) v[i] = __builtin_nontemporal_load((const f32x4*)(W + (size_t)(k0 + l8 + 8 * i) * N + ns + 4 * l7));
    if (kscale) {
#pragma unroll
        for (int i = 0; i < 8; ++i) v[i] = v[i] * kscale[k0 + l8 + 8 * i];
    }
    if (nscale) { const f32x4 sn = *(const f32x4*)(nscale + n0 + 4 * l7);
#pragma unroll
        for (int i = 0; i < 8; ++i) v[i] = v[i] * sn;
    }
#pragma unroll
    for (int i = 0; i < 8; ++i) { LAS float* d = scr + (l8 + 8 * i) * 33 + 4 * l7; d[0] = v[i].x; d[1] = v[i].y; d[2] = v[i].z; d[3] = v[i].w; }
    LDS_WAIT(); asm volatile("" ::: "memory");
    const int c = lane & 7;
#pragma unroll
    for (int j = 0; j < 4; ++j) { const int n = (lane >> 3) + 8 * j; const LAS float* s = scr + (8 * c) * 33 + n;
        v4u o; o.x = pk2(s[0 * 33], s[1 * 33]); o.y = pk2(s[2 * 33], s[3 * 33]); o.z = pk2(s[4 * 33], s[5 * 33]); o.w = pk2(s[6 * 33], s[7 * 33]);
        *(v4u*)(WT + (size_t)(row_off + n0 + n) * K + k0 + 8 * c) = o; }
    LDS_WAIT(); asm volatile("" ::: "memory");
}
__device__ __forceinline__ void rms_rows2_bf16(const float* x0, const float* x1, bool has1, const float* g, bf16* o0, bf16* o1, int lane) {
    const f32x4* xr0 = (const f32x4*)x0 + lane; const f32x4* xr1 = (const f32x4*)x1 + lane;
    f32x4 v[8], w[8]; float s0 = 0.f, s1 = 0.f;
#pragma unroll
    for (int j = 0; j < 8; ++j) v[j] = __builtin_nontemporal_load(xr0 + 64 * j);
    if (has1) {
#pragma unroll
        for (int j = 0; j < 8; ++j) w[j] = __builtin_nontemporal_load(xr1 + 64 * j);
    } else {
#pragma unroll
        for (int j = 0; j < 8; ++j) w[j] = (f32x4){0.f, 0.f, 0.f, 0.f};
    }
#pragma unroll
    for (int j = 0; j < 8; ++j) { s0 += (v[j].x * v[j].x + v[j].y * v[j].y) + (v[j].z * v[j].z + v[j].w * v[j].w); s1 += (w[j].x * w[j].x + w[j].y * w[j].y) + (w[j].z * w[j].z + w[j].w * w[j].w); }
    const float r0 = 1.f / sqrtf(wave_sum(s0) * (1.f / D) + EPS), r1 = 1.f / sqrtf(wave_sum(s1) * (1.f / D) + EPS);
    const f32x4* gr = (const f32x4*)g + lane;
    v2u* p0 = (v2u*)o0 + lane; v2u* p1 = (v2u*)o1 + lane;
#pragma unroll
    for (int j = 0; j < 8; ++j) { const f32x4 gv = gr[64 * j]; const f32x4 a = v[j] * r0 * gv; v2u q; q.x = pk2(a.x, a.y); q.y = pk2(a.z, a.w); p0[64 * j] = q;
        if (has1) { const f32x4 b = w[j] * r1 * gv; v2u q1; q1.x = pk2(b.x, b.y); q1.y = pk2(b.z, b.w); p1[64 * j] = q1; } }
}
__device__ __forceinline__ void rms_rows2_f32_inplace(float* x0, float* x1, bool has1, const float* g, int lane) {
    f32x4* xr0 = (f32x4*)x0 + lane; f32x4* xr1 = (f32x4*)x1 + lane;
    f32x4 v[8], w[8]; float s0 = 0.f, s1 = 0.f;
#pragma unroll
    for (int j = 0; j < 8; ++j) v[j] = xr0[64 * j];
    if (has1) {
#pragma unroll
        for (int j = 0; j < 8; ++j) w[j] = xr1[64 * j];
    } else {
#pragma unroll
        for (int j = 0; j < 8; ++j) w[j] = (f32x4){0.f, 0.f, 0.f, 0.f};
    }
#pragma unroll
    for (int j = 0; j < 8; ++j) { s0 += (v[j].x * v[j].x + v[j].y * v[j].y) + (v[j].z * v[j].z + v[j].w * v[j].w); s1 += (w[j].x * w[j].x + w[j].y * w[j].y) + (w[j].z * w[j].z + w[j].w * w[j].w); }
    const float r0 = 1.f / sqrtf(wave_sum(s0) * (1.f / D) + EPS), r1 = 1.f / sqrtf(wave_sum(s1) * (1.f / D) + EPS);
    const f32x4* gr = (const f32x4*)g + lane;
#pragma unroll
    for (int j = 0; j < 8; ++j) { const f32x4 gv = gr[64 * j]; xr0[64 * j] = v[j] * r0 * gv; if (has1) xr1[64 * j] = w[j] * r1 * gv; }
}

__device__ __forceinline__ F8 cvt_bf8(const v4u w) { F8 r; r.a = (f32x4){bflo(w.x), bfhi(w.x), bflo(w.y), bfhi(w.y)}; r.b = (f32x4){bflo(w.z), bfhi(w.z), bflo(w.w), bfhi(w.w)}; return r; }
__device__ __forceinline__ void rms_rows2_bf16_to_f32(const bf16* h0, const bf16* h1, bool has1, const float* g, float* o0, float* o1, int lane) {
    const v4u* r0 = (const v4u*)h0 + lane; const v4u* r1 = (const v4u*)h1 + lane;
    v4u a[4], b[4];
#pragma unroll
    for (int j = 0; j < 4; ++j) a[j] = __builtin_nontemporal_load(r0 + 64 * j);
    if (has1) {
#pragma unroll
        for (int j = 0; j < 4; ++j) b[j] = __builtin_nontemporal_load(r1 + 64 * j);
    } else {
#pragma unroll
        for (int j = 0; j < 4; ++j) b[j] = (v4u){0u, 0u, 0u, 0u};
    }
    F8 v[4], w[4]; float s0 = 0.f, s1 = 0.f;
#pragma unroll
    for (int j = 0; j < 4; ++j) { v[j] = cvt_bf8(a[j]); w[j] = cvt_bf8(b[j]);
        const f32x4 q0 = v[j].a * v[j].a + v[j].b * v[j].b, q1 = w[j].a * w[j].a + w[j].b * w[j].b; s0 += (q0.x + q0.y) + (q0.z + q0.w); s1 += (q1.x + q1.y) + (q1.z + q1.w); }
    const float i0 = 1.f / sqrtf(wave_sum(s0) * (1.f / D) + EPS), i1 = 1.f / sqrtf(wave_sum(s1) * (1.f / D) + EPS);
#pragma unroll
    for (int j = 0; j < 4; ++j) { const f32x4 ga = *((const f32x4*)g + 2 * (lane + 64 * j)), gb = *((const f32x4*)g + 2 * (lane + 64 * j) + 1);
        f32x4* p0 = (f32x4*)o0 + 2 * (lane + 64 * j); __builtin_nontemporal_store(v[j].a * i0 * ga, p0); __builtin_nontemporal_store(v[j].b * i0 * gb, p0 + 1);
        if (has1) { f32x4* p1 = (f32x4*)o1 + 2 * (lane + 64 * j); __builtin_nontemporal_store(w[j].a * i1 * ga, p1); __builtin_nontemporal_store(w[j].b * i1 * gb, p1 + 1); } }
}

__device__ __forceinline__ void mixer_item_generic(int j, int c, const bf16* PROJ, const float* cache_pool, const float* cache_conv, const float* conv_w, bf16* DMAT, bf16* MIX, float* out) {
    const bool samp = j >= MPO; int b, t; size_t prow;
    if (!samp) { b = j >> 11; t = j & 2047; prow = (size_t)b * LP + NMETA + t; }
    else { const int s = j - MPO; b = s >> 5; t = s & 31; prow = (size_t)MP + s; }
    if (c < 128) {
        const int ch = c * 8, w = 2 << (c >> 5);
        const bf16* base = PROJ + prow * LDP + ch;
        const F8 u = ld_bf8(base); F8 sum = u;
        for (int k = 1; k < w; ++k) {
            F8 e;
            if (!samp || t - k >= 0) e = ld_bf8(base - (size_t)k * LDP);
            else e = ld_f8(cache_pool + ((size_t)b * 15 + (15 + t - k)) * PW + ch);
            sum.a += e.a; sum.b += e.b;
        }
        const float inv = 1.f / (float)w;
        F8 d; d.a = sum.a * inv - u.a; d.b = sum.b * inv - u.b;
        st_bf8(DMAT + (size_t)j * PW + ch, d);
        if (!samp) { if (t >= SEQ - 15) st_f8(out + O_SPP + ((size_t)b * 15 + (t - (SEQ - 15))) * PW + ch, u); }
        else { if (t >= SL - 15) st_f8(out + O_SPS + ((size_t)b * 15 + (t - (SL - 15))) * PW + ch, u); }
    } else {
        const int ch = (c - 128) * 8;
        const bf16* base = PROJ + prow * LDP + ch;
        const F8 bg = ld_bf8(base + PW), z0 = ld_bf8(base + ZOFF(ch));
        F8 z1, z2;
        if (!samp || t >= 1) z1 = ld_bf8(base - LDP + ZOFF(ch)); else z1 = ld_f8(cache_conv + ((size_t)b * 2 + 1) * CW + ch);
        if (!samp || t >= 2) z2 = ld_bf8(base - 2 * (size_t)LDP + ZOFF(ch)); else z2 = ld_f8(cache_conv + ((size_t)b * 2 + t) * CW + ch);
        const F8 w0 = ld_f8(conv_w + ch), w1 = ld_f8(conv_w + CW + ch), w2 = ld_f8(conv_w + 2 * CW + ch);
        F8 y; y.a = bg.a * (z2.a * w0.a + z1.a * w1.a + z0.a * w2.a); y.b = bg.b * (z2.b * w0.b + z1.b * w1.b + z0.b * w2.b);
        st_bf8(MIX + (size_t)j * D + PW + ch, y);
        if (!samp) { if (t >= SEQ - 2) st_f8(out + O_SCP + ((size_t)b * 2 + (t - (SEQ - 2))) * CW + ch, z0); }
        else { if (t >= SL - 2) st_f8(out + O_SCS + ((size_t)b * 2 + (t - (SL - 2))) * CW + ch, z0); }
    }
}
template <int W> __device__ __forceinline__ void pool_rows4_prompt(const bf16* PROJ, bf16* DMAT, float* out, int j0, int ch) {
    const int b = j0 >> 11, t0 = j0 & 2047;
    const bf16* base = PROJ + ((size_t)b * LP + NMETA + t0 + 3) * LDP + ch;
    v4u raw[W + 3];
#pragma unroll
    for (int k = 0; k < W + 3; ++k) raw[k] = *(const v4u*)(base - (size_t)k * LDP);
    F8 S = cvt_bf8(raw[3]);
#pragma unroll
    for (int k = 4; k < W + 3; ++k) { const F8 e = cvt_bf8(raw[k]); S.a += e.a; S.b += e.b; }
    const float inv = 1.f / (float)W;
#pragma unroll
    for (int i = 0; i < 4; ++i) {
        const F8 u = cvt_bf8(raw[3 - i]);
        if (i > 0) { const F8 o = cvt_bf8(raw[W + 3 - i]); S.a += u.a - o.a; S.b += u.b - o.b; }
        F8 d; d.a = S.a * inv - u.a; d.b = S.b * inv - u.b;
        st_bf8(DMAT + (size_t)(j0 + i) * PW + ch, d);
        if (t0 + i >= SEQ - 15) st_f8(out + O_SPP + ((size_t)b * 15 + (t0 + i - (SEQ - 15))) * PW + ch, u);
    }
}
__device__ __forceinline__ void conv_rows4_prompt(const bf16* PROJ, const float* conv_w, bf16* MIX, float* out, int j0, int ch) {
    const int b = j0 >> 11, t0 = j0 & 2047;
    const bf16* base = PROJ + ((size_t)b * LP + NMETA + t0) * LDP + ch;
    v4u rz[6], rb[4];
#pragma unroll
    for (int k = 0; k < 6; ++k) rz[k] = *(const v4u*)(base + (ptrdiff_t)(k - 2) * LDP + ZOFF(ch));
#pragma unroll
    for (int i = 0; i < 4; ++i) rb[i] = *(const v4u*)(base + (size_t)i * LDP + PW);
    const F8 w0 = ld_f8(conv_w + ch), w1 = ld_f8(conv_w + CW + ch), w2 = ld_f8(conv_w + 2 * CW + ch);
    F8 z[6];
#pragma unroll
    for (int k = 0; k < 6; ++k) z[k] = cvt_bf8(rz[k]);
#pragma unroll
    for (int i = 0; i < 4; ++i) {
        const F8 bg = cvt_bf8(rb[i]);
        F8 y; y.a = bg.a * (z[i].a * w0.a + z[i + 1].a * w1.a + z[i + 2].a * w2.a); y.b = bg.b * (z[i].b * w0.b + z[i + 1].b * w1.b + z[i + 2].b * w2.b);
        st_bf8(MIX + (size_t)(j0 + i) * D + PW + ch, y);
        if (t0 + i >= SEQ - 2) st_f8(out + O_SCP + ((size_t)b * 2 + (t0 + i - (SEQ - 2))) * CW + ch, z[i + 2]);
    }
}

#define XB_TMO      128
#define XB_XCNT(j)  (256  + 64 * (j))
#define XB_XSUB(j)  (1280 + 64 * (j))
#define XB_XGEN(j)  (2304 + 64 * (j))
#define XB_TOP      3328
#define XB_TOPGEN   3392
#define XCD_BAR_WORDS 3456
#define XB_SPIN_CAP (1u << 20)
__device__ __forceinline__ unsigned xb_ld(unsigned* p)              { return __hip_atomic_load(p, __ATOMIC_RELAXED, __HIP_MEMORY_SCOPE_AGENT); }
__device__ __forceinline__ unsigned xb_add(unsigned* p, unsigned v) { return __hip_atomic_fetch_add(p, v, __ATOMIC_RELAXED, __HIP_MEMORY_SCOPE_AGENT); }
__device__ __forceinline__ unsigned xb_xcc_id() { return (unsigned)__builtin_amdgcn_s_getreg((3 << 11) | 20) & 0xFu; }
#define XB_SPIN(cond, bar) do { unsigned _sp = 0; while (cond) { __builtin_amdgcn_s_sleep(1); \
    if ((++_sp & 255u) == 0u) { if (xb_ld(&(bar)[XB_TMO])) break; if (_sp > XB_SPIN_CAP) { atomicAdd(&(bar)[XB_TMO], 1u); break; } } } } while (0)
__device__ __forceinline__ void xcd_barrier_post(unsigned* bar) { if (threadIdx.x == 0) (void)xb_add(&bar[XB_XCNT(xb_xcc_id())], 1u); }
__device__ __forceinline__ void xcd_barrier_complete(unsigned* bar, unsigned x, unsigned& nloc, unsigned& nx) {
    const unsigned G = gridDim.x * gridDim.y * gridDim.z;
    unsigned sum, cnt, mine, sp = 0u;
    for (;;) {
        sum = 0u; cnt = 0u; mine = 0u;
#pragma unroll
        for (unsigned j = 0; j < 16; ++j) { const unsigned c = xb_ld(&bar[XB_XCNT(j)]); sum += c; cnt += (c > 0u) ? 1u : 0u; mine = (j == x) ? c : mine; }
        if (sum == G) break;
        __builtin_amdgcn_s_sleep(1);
        if ((++sp & 255u) == 0u) { if (xb_ld(&bar[XB_TMO])) break; if (sp > XB_SPIN_CAP) { atomicAdd(&bar[XB_TMO], 1u); break; } }
    }
    nloc = mine > 0u ? mine : 1u; nx = cnt > 0u ? cnt : 1u;
}
__device__ __forceinline__ void xcd_barrier(unsigned* bar, volatile LAS unsigned* st) {
    asm volatile("s_waitcnt vmcnt(0)" ::: "memory");
    __syncthreads();
    if (threadIdx.x == 0) {
        const unsigned x = xb_xcc_id();
        __builtin_amdgcn_s_waitcnt(0);
        unsigned nloc = st[0], nx = st[1];
        if (nloc == 0u) { xcd_barrier_complete(bar, x, nloc, nx); st[0] = nloc; st[1] = nx; }
        const unsigned old = xb_add(&bar[XB_XSUB(x)], 1u);
        const unsigned gen = old / nloc;
        if (old + 1u == (gen + 1u) * nloc) {
            __builtin_amdgcn_fence(__ATOMIC_RELEASE, "agent");
            asm volatile("s_waitcnt vmcnt(0)" ::: "memory");
            const unsigned og = xb_add(&bar[XB_TOP], 1u);
            const unsigned tg = og / nx;
            if (og + 1u == (tg + 1u) * nx) xb_add(&bar[XB_TOPGEN], 1u);
            else XB_SPIN(xb_ld(&bar[XB_TOPGEN]) == tg, bar);
            __builtin_amdgcn_fence(__ATOMIC_ACQUIRE, "agent");
            xb_add(&bar[XB_XGEN(x)], 1u);
            asm volatile("s_waitcnt vmcnt(0)" ::: "memory");
        } else {
            XB_SPIN(xb_ld(&bar[XB_XGEN(x)]) == gen, bar);
            __builtin_amdgcn_fence(__ATOMIC_ACQUIRE, "agent");
            asm volatile("s_waitcnt vmcnt(0)" ::: "memory");
        }
    }
    __syncthreads();
}

struct Args { const float* in[15]; float* out; unsigned char* ws; };

__global__ void __launch_bounds__(512, 2) mega_fwd(Args args) {
    extern __shared__ __attribute__((aligned(16))) unsigned char lds_raw[];
    cg::grid_group grid = cg::this_grid();
    LAS unsigned char* lds = (LAS unsigned char*)lds_raw;
    const int G = gridDim.x, bx = blockIdx.x, NGW = G * 8;
    if (threadIdx.x < 2) ((volatile LAS unsigned*)(lds + 131072 + 64))[threadIdx.x] = 0u;
    __syncthreads();
    xcd_barrier_post((unsigned*)(args.ws + WS_CTL));
#define GRID_BAR() xcd_barrier((unsigned*)(args.ws + WS_CTL), (volatile LAS unsigned*)(lds + 131072 + 64))
    unsigned char* ws = args.ws;
    const float* xp = args.in[0]; const float* xs = args.in[1]; const float* cache_pool = args.in[2]; const float* cache_conv = args.in[3];
    const float* meta = args.in[4]; const float* norm1_g = args.in[5]; const float* w_in = args.in[6]; const float* w_pool = args.in[7];
    const float* pool_scale = args.in[8]; const float* conv_w = args.in[9]; const float* w_out = args.in[10]; const float* norm2_g = args.in[11];
    const float* w_up = args.in[12]; const float* w_down = args.in[13]; const float* final_g = args.in[14];
    float* out = args.out;
    bf16* WIN = (bf16*)(ws + WS_WIN); bf16* WOUT = (bf16*)(ws + WS_WOUT); bf16* WUP = (bf16*)(ws + WS_WUP); bf16* WDOWN = (bf16*)(ws + WS_WDOWN); bf16* WPOOL = (bf16*)(ws + WS_WPOOL);
    bf16* HN = (bf16*)(ws + WS_HN); bf16* PROJ = (bf16*)(ws + WS_PROJ); bf16* DMAT = (bf16*)(ws + WS_DMAT); bf16* MIX = (bf16*)(ws + WS_MIX); bf16* ACT = (bf16*)(ws + WS_BIG);

    {
        int tid0 = threadIdx.x; asm volatile("" : "+v"(tid0)); const int lane = tid0 & 63, wave = __builtin_amdgcn_readfirstlane(tid0 >> 6), gw = bx * 8 + wave;
        LAS float* scr = (LAS float*)(lds + wave * 16384);
        constexpr int I_IN = (D / 64) * (INW / 32), I_OUT = (D / 64) * (D / 32), I_PG = (PGC / 64) * (PGC / 32);
        constexpr int NITEMS = I_IN + I_OUT + 4 * I_PG;
        for (int i = bx * 512 + tid0; i < M2; i += G * 512) ((float*)(ws + WS_SSQ))[i] = 0.f;
        for (int it = gw; it < NITEMS; it += NGW) {
            int r = it;
            if (r < I_IN) { p0_transpose_item(w_in, D, INW, WIN, 0, scr, r, lane, true); continue; } r -= I_IN;
            if (r < I_OUT) { p0_transpose_item(w_out, D, D, WOUT, 0, scr, r, lane); continue; } r -= I_OUT;
            const int gq = r / I_PG; r -= gq * I_PG;
            p0_transpose_item(w_pool + (size_t)gq * PGC * PGC, PGC, PGC, WPOOL, gq * PGC, scr, r, lane, false, nullptr, pool_scale + gq * PGC);
        }
        for (int p = gw; p < M1; p += 2 * NGW) {
            const int p1 = p + NGW; const bool has1 = p1 < M1; const int pc = has1 ? p1 : p;
            const float* xr0; const float* xr1;
            if (p < MP) { const int b = p / LP, pos = p - b * LP; xr0 = pos < NMETA ? meta + (size_t)pos * D : xp + ((size_t)b * SEQ + (pos - NMETA)) * D; }
            else xr0 = xs + (size_t)(p - MP) * D;
            if (pc < MP) { const int b = pc / LP, pos = pc - b * LP; xr1 = pos < NMETA ? meta + (size_t)pos * D : xp + ((size_t)b * SEQ + (pos - NMETA)) * D; }
            else xr1 = xs + (size_t)(pc - MP) * D;
            rms_rows2_bf16(xr0, xr1, has1, norm1_g, HN + (size_t)p * D, HN + (size_t)pc * D, lane);
        }
    }
    GRID_BAR();
    if (out == nullptr) grid.sync();

    const bool ov = (G == 256);
    unsigned* sig2 = (unsigned*)(ws + WS_CTL) + 6144;
    unsigned* sigT = (unsigned*)(ws + WS_CTL) + 7680;
    for (int st = 0; st < 6; ++st) {
        if (st == 4 && !ov) continue;
        const int gi = st < 4 ? st : st - 1;
        if (gi == 1) {
            {
                int tid2 = threadIdx.x; asm volatile("" : "+v"(tid2));
                const int lane = tid2 & 63, gw = bx * 8 + __builtin_amdgcn_readfirstlane(tid2 >> 6), half = lane >> 5, l31 = lane & 31;
                const int cb = gw & 7, vb = ((G & 7) == 0) ? (bx & 7) * (G >> 3) + (bx >> 3) : bx;
                for (int q = vb; q < MPO / 8; q += G) {
                    const int j0 = 8 * q + 4 * half;
                    if (cb == 0) pool_rows4_prompt<2>(PROJ, DMAT, out, j0, l31 * 8);
                    else if (cb == 1) pool_rows4_prompt<4>(PROJ, DMAT, out, j0, (32 + l31) * 8);
                    else if (cb == 2) pool_rows4_prompt<8>(PROJ, DMAT, out, j0, (64 + l31) * 8);
                    else if (cb == 3) pool_rows4_prompt<16>(PROJ, DMAT, out, j0, (96 + l31) * 8);
                    else conv_rows4_prompt(PROJ, conv_w, MIX, out, j0, ((cb - 4) * 32 + l31) * 8);
                }
                for (int rp = vb; rp < MS / 2; rp += G) mixer_item_generic(MPO + 2 * rp + half, cb * 32 + l31, PROJ, cache_pool, cache_conv, conv_w, DMAT, MIX, out);
            }

            GRID_BAR();
        }
        pg8::Gemm g; pg8::EpiAny E;
        E.scale = pool_scale; E.xp = xp; E.xs = xs; E.out = out; E.O = PROJ; E.ldc = LDP; E.mode = 0; E.ssq = (float*)(ws + WS_SSQ); E.zpn0 = (gi == 0) ? 2 * PW / 256 : (1 << 30);
        switch (gi) {
        case 0:  g = pg8::Gemm{HN, WIN, M1, INW, D, D, D, 0}; break;
        case 1:  g = pg8::Gemm{DMAT, WPOOL, M2, PW, PGC, PW, PGC, PGC}; E.mode = 0; E.O = MIX; E.ldc = D; break;
        case 2:  g = pg8::Gemm{MIX, WOUT, M2, D, D, D, D, 0}; E.mode = 4; E.O = HN; E.ldc = D; break;
        case 3:  g = pg8::Gemm{HN, WUP, M2, FF, D, D, D, 0}; E.mode = 1; E.O = ACT; E.ldc = FF; break;
        default: g = pg8::Gemm{ACT, WDOWN, M2, D, FF, FF, FF, 0}; E.mode = 5; E.O = HN; E.ldc = D; break;
        }
        const bool tail4 = (gi == 4 && G == 256), tail2 = (gi == 2 && ov);
        unsigned* sig = (unsigned*)(ws + WS_CTL) + 4096;
        pg8::StaticOrder S;
        volatile LAS unsigned* bst = (volatile LAS unsigned*)(lds + 131072 + 64);
        const int wgm = (gi == 0 || gi == 3) ? WGM_A : WGM_B;
        if (tail4) S.init(MPO, g.N, G, bx, wgm, (M2 - MPO) / 256, sig, 3, bst[0]);
        else if (tail2) S.init(MPO, g.N, G, bx, wgm, (M2 - MPO) / 256, sig2, 3, bst[0]);
        else if (st == 3 && ov) S.init(MPO, g.N, G, bx, wgm);
        else if (st == 4) {
            if (bx >= 128 && threadIdx.x == 0) { unsigned sp = 0;
                while (__hip_atomic_load(sigT, __ATOMIC_RELAXED, __HIP_MEMORY_SCOPE_AGENT) < 32u) { __builtin_amdgcn_s_sleep(2); if (++sp > (1u << 22)) break; }
                __builtin_amdgcn_fence(__ATOMIC_ACQUIRE, "agent"); asm volatile("s_waitcnt vmcnt(0)" ::: "memory"); }
            __syncthreads();
            S.init(MPO, g.N, G, (bx + 128) & 255, wgm, (M2 - MPO) / 256, nullptr, -1, 0, (MPO / 256) * (FF / 256) / 256);
        }
        else S.init(g.M, g.N, G, bx, wgm);
        pg8::gemm_phase<pg8::EpiAny, pg8::StaticOrder, PG8_ALIGN, PG8_SP2>(lds, g, S, E);
        if (gi == 0) {
            constexpr int I_UP = (D / 64) * (FF / 32), I_DOWN = (FF / 64) * (D / 32);
            const int rem = ((M1 / 256) * (INW / 256)) % G, n_idle = rem ? G - rem : G, ic = rem ? bx - rem : bx;
            if (ic >= 0) {
                int tidb = threadIdx.x; asm volatile("" : "+v"(tidb)); const int lane = tidb & 63, wave = __builtin_amdgcn_readfirstlane(tidb >> 6);
                LAS float* scr = (LAS float*)(lds + wave * 16384);
                for (int it = ic * 8 + wave; it < I_UP + I_DOWN; it += n_idle * 8) {
                    if (it < I_UP) p0_transpose_item(w_up, D, FF, WUP, 0, scr, it, lane, false, norm2_g);
                    else p0_transpose_item(w_down, FF, D, WDOWN, 0, scr, it - I_UP, lane);
                }
            }
        }
        if (tail4 && bx >= S.ntail) {
            if (threadIdx.x == 0) {
                unsigned sp = 0; const unsigned want = bst[1];
                while (__hip_atomic_load(sig, __ATOMIC_RELAXED, __HIP_MEMORY_SCOPE_AGENT) < want) { __builtin_amdgcn_s_sleep(2); if (++sp > (1u << 22)) break; }
                __builtin_amdgcn_fence(__ATOMIC_ACQUIRE, "agent");
                asm volatile("s_waitcnt vmcnt(0)" ::: "memory");
            }
            __syncthreads();
            int tidc = threadIdx.x; asm volatile("" : "+v"(tidc)); const int lane = tidc & 63, iw = (bx - S.ntail) * 8 + __builtin_amdgcn_readfirstlane(tidc >> 6), nw = (G - S.ntail) * 8;
            for (int p = iw; p < MPO; p += 2 * nw) { const int p1 = p + nw; const bool has1 = p1 < MPO; const int pc = has1 ? p1 : p;
                rms_rows2_bf16_to_f32(HN + (size_t)p * D, HN + (size_t)pc * D, has1, final_g, out + (size_t)p * D, out + (size_t)pc * D, lane); }
        }
        if (tail2) {
            if (bx < S.ntail) { asm volatile("s_waitcnt vmcnt(0)" ::: "memory"); __syncthreads();
                if (threadIdx.x == 0) { __builtin_amdgcn_fence(__ATOMIC_RELEASE, "agent"); asm volatile("s_waitcnt vmcnt(0)" ::: "memory"); __hip_atomic_fetch_add(sigT, 1u, __ATOMIC_RELAXED, __HIP_MEMORY_SCOPE_AGENT); } }
            if (threadIdx.x == 0) { unsigned sp = 0; const unsigned want = bst[1];
                while (__hip_atomic_load(sig2, __ATOMIC_RELAXED, __HIP_MEMORY_SCOPE_AGENT) < want) { __builtin_amdgcn_s_sleep(2); if (++sp > (1u << 22)) break; }
                __builtin_amdgcn_fence(__ATOMIC_ACQUIRE, "agent"); asm volatile("s_waitcnt vmcnt(0)" ::: "memory"); }
            __syncthreads();
        }
        else if (st == 3 && ov) { }
        else GRID_BAR();
    }

    int tid8 = threadIdx.x; asm volatile("" : "+v"(tid8)); const int lane = tid8 & 63, gw = bx * 8 + __builtin_amdgcn_readfirstlane(tid8 >> 6);
    for (int p = (G == 256 ? MPO : 0) + gw; p < M2; p += 2 * NGW) { const int p1 = p + NGW; const bool has1 = p1 < M2; const int pc = has1 ? p1 : p;
        rms_rows2_bf16_to_f32(HN + (size_t)p * D, HN + (size_t)pc * D, has1, final_g, out + (size_t)p * D, out + (size_t)pc * D, lane); }
}

extern "C" void kernel_launch(void* const* d_in, const int* in_sizes, int n_in, void* d_out, int out_size, void* d_ws, size_t ws_size, hipStream_t stream) {
    static int grid = 0;
    if (grid == 0) {
        if (n_in != 15 || ws_size < WS_END) { fprintf(stderr, "kernel_launch: unexpected n_in %d / ws_size %zu (need %zu)\n", n_in, ws_size, (size_t)WS_END); grid = -1; return; }
        int dev = 0, cus = 0, per_cu = 0;
        if (hipGetDevice(&dev) != hipSuccess || hipDeviceGetAttribute(&cus, hipDeviceAttributeMultiprocessorCount, dev) != hipSuccess) { grid = -1; return; }
        if (hipFuncSetAttribute((const void*)mega_fwd, hipFuncAttributeMaxDynamicSharedMemorySize, LDS_BYTES) != hipSuccess) { fprintf(stderr, "kernel_launch: hipFuncSetAttribute failed\n"); grid = -1; return; }
        if (hipOccupancyMaxActiveBlocksPerMultiprocessor(&per_cu, (const void*)mega_fwd, 512, LDS_BYTES) != hipSuccess || per_cu < 1) { fprintf(stderr, "kernel_launch: occupancy query says %d\n", per_cu); per_cu = 1; }
        (void)hipGetLastError();
        grid = cus * per_cu;
    }
    if (grid < 0) return;
    if (hipMemsetAsync((char*)d_ws + WS_CTL, 0, 65536, stream) != hipSuccess) { fprintf(stderr, "kernel_launch: memset failed\n"); return; }
    Args a{};
    for (int i = 0; i < 15; ++i) a.in[i] = (const float*)d_in[i];
    a.out = (float*)d_out; a.ws = (unsigned char*)d_ws;
    void* kargs[] = {&a};
    hipError_t e = hipLaunchCooperativeKernel((const void*)mega_fwd, dim3(grid), dim3(512), kargs, LDS_BYTES, stream);
    if (e != hipSuccess) fprintf(stderr, "kernel_launch: cooperative launch failed: %s (grid %d)\n", hipGetErrorString(e), grid);
}
```

```cpp
#include <hip/hip_runtime.h>
#include <hip/hip_cooperative_groups.h>
#include <cstdio>
#include <cstdint>
namespace cg = cooperative_groups;

constexpr int D = 2048, NB = 16, SEQ = 2048, NMETA = 16, LP = SEQ + NMETA, SB = 32, SL = 32;
constexpr int MP = NB * LP;
constexpr int MS = SB * SL;
constexpr int M1 = MP + MS;
constexpr int MPO = NB * SEQ;
constexpr int M2 = MPO + MS;
constexpr int INW = 4096, PW = 1024, CW = 1024, FF = 8192, PGC = 256;
constexpr int LDP = INW;
#define ZOFF(ch) (2 * PW + 128 * ((ch) >> 7))
constexpr float EPS = 1e-6f;
static_assert(M1 % 256 == 0 && M2 % 256 == 0, "row tiles");

constexpr size_t MiB = 1u << 20;
constexpr size_t WS_CTL = 0;
constexpr size_t WS_WIN = 1 * MiB;
constexpr size_t WS_WOUT = 17 * MiB;
constexpr size_t WS_WUP = 25 * MiB;
constexpr size_t WS_WDOWN = 57 * MiB;
constexpr size_t WS_WPOOL = 89 * MiB;
constexpr size_t WS_SSQ = 90 * MiB;
constexpr size_t WS_HN = 91 * MiB;
constexpr size_t WS_BIG = 224 * MiB;
constexpr size_t WS_PROJ = WS_BIG;
constexpr size_t WS_DMAT = WS_BIG + 266 * MiB;
constexpr size_t WS_MIX = WS_BIG + 528 * MiB;
constexpr size_t WS_END = WS_MIX + 132 * MiB;
static_assert(WS_HN + (size_t)M1 * D * 2 <= WS_BIG && WS_PROJ + (size_t)M1 * LDP * 2 <= WS_DMAT && WS_MIX + (size_t)M2 * D * 2 <= WS_END && (size_t)M2 * FF * 2 <= 528 * MiB && WS_DMAT + (size_t)M2 * PW * 2 <= WS_BIG + 528 * MiB, "ws map");

constexpr size_t O_Y = 0;
constexpr size_t O_SPP = (size_t)M2 * D;
constexpr size_t O_SCP = O_SPP + (size_t)NB * 15 * PW;
constexpr size_t O_SPS = O_SCP + (size_t)NB * 2 * CW;
constexpr size_t O_SCS = O_SPS + (size_t)SB * 15 * PW;

#ifndef WGM_A
#define WGM_A 4
#endif
#ifndef WGM_B
#define WGM_B 4
#endif
constexpr int LDS_BYTES = 135168;

namespace pg8 {
#define PG8_LAS __attribute__((address_space(3)))
typedef unsigned short bf16_t;
typedef short bf16x8 __attribute__((ext_vector_type(8)));
typedef float f32x4 __attribute__((ext_vector_type(4)));
typedef unsigned u32x4 __attribute__((ext_vector_type(4)));
constexpr int BM = 256, BK = 64, HALF = 128, HTB = HALF * BK * 2, STAGE_BYTES = 8 * HTB, NXCD = 8;

__host__ __device__ __forceinline__ int lds_byte(int r, int c) { const int st = (r >> 4) * 2 + (c >> 5), rr = r & 15, cc = c & 31, ob = rr * 64 + cc * 2; return st * 1024 + (ob ^ (((ob >> 9) & 1) << 5)); }
__host__ __device__ __forceinline__ void stage_rc(int b, int& R, int& C) { const int st = b / 1024, sb = b % 1024, swz = sb ^ (((sb >> 9) & 1) << 5); R = (st >> 1) * 16 + swz / 64; C = (st & 1) * 32 + (swz % 64) / 2; }
__host__ __device__ __forceinline__ int perm32(int rho) { const int n = rho >> 4, i = rho & 15; return 8 * (i >> 2) + 4 * n + (i & 3); }

struct Unit { int pm, pn, boff1; };
struct Gemm { const bf16_t* A; const bf16_t* Bt; int M, N, K, lda, ldb, apn; };

struct StaticOrder {
    int nM, nN, nwg, G, c, tail_round, ntail, sig_ui, WGM, round0; unsigned* sig; unsigned nloc;
    __host__ __device__ void init(int M, int N, int G_, int c_, int wgm, int tail_panels = 0, unsigned* sig_ = nullptr, int sig_ui_ = -1, unsigned nloc_ = 0, int round0_ = 0) {
        WGM = wgm; round0 = round0_;
        nM = M / BM; nN = N / BM; nwg = nM * nN; G = G_; c = c_; tail_round = tail_panels ? nwg / G : -1; ntail = tail_panels * nN; sig = sig_; sig_ui = sig_ui_; nloc = nloc_; }
    __host__ __device__ bool next(int i_, Unit& u) const {
        const int i = i_ + round0; const bool tl = (i == tail_round);
        const long L = (long)i * G + c; const bool ok = tl ? (c < ntail) : (L < nwg);
        int wgid = (int)(L < nwg ? L : 0); { const int q = nwg / NXCD, r = nwg % NXCD, xcd = wgid % NXCD, off = wgid / NXCD; wgid = (xcd < r ? xcd * (q + 1) : r * (q + 1) + (xcd - r) * q) + off; }
        const int nig = WGM * nN, gid = wgid / nig, fm = gid * WGM, gsz = (nM - fm) < WGM ? (nM - fm) : WGM;
        const int pm = fm + ((wgid % nig) % gsz), pn = (wgid % nig) / gsz;
        u.pm = tl ? nM + c / nN : pm; u.pn = tl ? c % nN : pn;
        return ok;
    }
    __device__ __forceinline__ void a_ready(const Unit&) const {}
    __device__ __forceinline__ void done(const Unit&, int ui) const {
        if (sig != nullptr && ui == sig_ui) {
            asm volatile("s_waitcnt vmcnt(0)" ::: "memory");
            __builtin_amdgcn_s_barrier();
            if (threadIdx.x == 0) {
                const unsigned x = (unsigned)__builtin_amdgcn_s_getreg((3 << 11) | 20) & 0xFu;
                const unsigned old = __hip_atomic_fetch_add(sig + 64 * (1 + x), 1u, __ATOMIC_RELAXED, __HIP_MEMORY_SCOPE_AGENT);
                if (old + 1u == nloc) {
                    __builtin_amdgcn_fence(__ATOMIC_RELEASE, "agent");
                    asm volatile("s_waitcnt vmcnt(0)" ::: "memory");
                    __hip_atomic_fetch_add(sig, 1u, __ATOMIC_RELAXED, __HIP_MEMORY_SCOPE_AGENT);
                }
            }
        }
    }
};

__device__ __forceinline__ unsigned cvt_pk_bf16(float lo, float hi) { unsigned r; asm volatile("v_cvt_pk_bf16_f32 %0, %1, %2" : "=v"(r) : "v"(lo), "v"(hi)); return r; }

struct EpiAny {
    static constexpr bool AFTER_DRAIN = false;
    int mode; bf16_t* O; int ldc; const float* scale; const float* xp; const float* xs; float* out; float* ssq; int zpn0;
    __device__ __forceinline__ bool perm() const { return true; }
    __device__ __forceinline__ void operator()(const f32x4 (&acc)[2][2][4][2], const Unit& u, int wr, int wc, int fr, int fq) const {
        const int row0 = u.pm * BM + wr * 64 + fr, col0 = u.pn * BM + wc * 32 + 8 * fq;
        if (mode == 4) {
            float ss[2][4];
#pragma unroll
            for (int ai = 0; ai < 2; ++ai)
#pragma unroll
                for (int m = 0; m < 4; ++m) ss[ai][m] = 0.f;
#pragma unroll
            for (int bj = 0; bj < 2; ++bj) {
#pragma unroll
                for (int ai = 0; ai < 2; ++ai)
#pragma unroll
                    for (int m = 0; m < 4; ++m) { const int row = row0 + ai * HALF + m * 16;
                        const float* xr = (row < MPO ? xp + (size_t)row * D : xs + (size_t)(row - MPO) * D) + col0 + bj * HALF;
                        const f32x4 h0 = __builtin_nontemporal_load((const f32x4*)xr) + acc[ai][bj][m][0], h1 = __builtin_nontemporal_load((const f32x4*)(xr + 4)) + acc[ai][bj][m][1];
                        ss[ai][m] += ((h0[0] * h0[0] + h0[1] * h0[1]) + (h0[2] * h0[2] + h0[3] * h0[3])) + ((h1[0] * h1[0] + h1[1] * h1[1]) + (h1[2] * h1[2] + h1[3] * h1[3]));
                        u32x4 w; w.x = cvt_pk_bf16(h0[0], h0[1]); w.y = cvt_pk_bf16(h0[2], h0[3]); w.z = cvt_pk_bf16(h1[0], h1[1]); w.w = cvt_pk_bf16(h1[2], h1[3]);
                        *(u32x4*)(O + (size_t)row * ldc + col0 + bj * HALF) = w;
                        if (m & 1) asm volatile("" ::: "memory"); }
            }
#pragma unroll
            for (int ai = 0; ai < 2; ++ai)
#pragma unroll
                for (int m = 0; m < 4; ++m) { float sr = ss[ai][m]; sr += __shfl_xor(sr, 16); sr += __shfl_xor(sr, 32);
                    if (fq == 0) __hip_atomic_fetch_add(ssq + row0 + ai * HALF + m * 16, sr, __ATOMIC_RELAXED, __HIP_MEMORY_SCOPE_AGENT); }
        } else if (mode == 5) {
            float ri[2][4];
#pragma unroll
            for (int ai = 0; ai < 2; ++ai)
#pragma unroll
                for (int m = 0; m < 4; ++m) ri[ai][m] = 1.f / (ssq[row0 + ai * HALF + m * 16] * (1.f / D) + EPS);
#pragma unroll
            for (int bj = 0; bj < 2; ++bj)
#pragma unroll
                for (int ai = 0; ai < 2; ++ai)
#pragma unroll
                    for (int m = 0; m < 4; ++m) { const int row = row0 + ai * HALF + m * 16; const u32x4 hb = *(const u32x4*)(O + (size_t)row * ldc + col0 + bj * HALF);
                        const f32x4 r0 = (f32x4){__uint_as_float(hb.x << 16), __uint_as_float(hb.x & 0xffff0000u), __uint_as_float(hb.y << 16), __uint_as_float(hb.y & 0xffff0000u)};
                        const f32x4 r1 = (f32x4){__uint_as_float(hb.z << 16), __uint_as_float(hb.z & 0xffff0000u), __uint_as_float(hb.w << 16), __uint_as_float(hb.w & 0xffff0000u)};
                        const f32x4 v0 = r0 + acc[ai][bj][m][0] * ri[ai][m], v1 = r1 + acc[ai][bj][m][1] * ri[ai][m];
                        u32x4 w; w.x = cvt_pk_bf16(v0[0], v0[1]); w.y = cvt_pk_bf16(v0[2], v0[3]); w.z = cvt_pk_bf16(v1[0], v1[1]); w.w = cvt_pk_bf16(v1[2], v1[3]);
                        __builtin_nontemporal_store(w, (u32x4*)(O + (size_t)row * ldc + col0 + bj * HALF));
                        if (m & 1) asm volatile("" ::: "memory"); }
        } else {
            const int boff1 = u.boff1;
#pragma unroll
            for (int bj = 0; bj < 2; ++bj) {
                f32x4 sv0 = (f32x4){1.f, 1.f, 1.f, 1.f}, sv1 = sv0;
                if (mode == 2) { sv0 = *(const f32x4*)(scale + col0 + bj * HALF); sv1 = *(const f32x4*)(scale + col0 + bj * HALF + 4); }
#pragma unroll
                for (int ai = 0; ai < 2; ++ai)
#pragma unroll
                    for (int m = 0; m < 4; ++m) { bf16_t* rowp = O + (size_t)(row0 + ai * HALF + m * 16) * ldc + col0;
                        f32x4 v0 = acc[ai][bj][m][0], v1 = acc[ai][bj][m][1];
                        if (mode == 1) {
#pragma unroll
                            for (int j = 0; j < 4; ++j) { const float a = fmaxf(v0[j], 0.f), b = fmaxf(v1[j], 0.f); v0[j] = a * a; v1[j] = b * b; } }
                        if (mode == 2) { v0 = v0 * sv0; v1 = v1 * sv1; }
                        u32x4 w; w.x = cvt_pk_bf16(v0[0], v0[1]); w.y = cvt_pk_bf16(v0[2], v0[3]); w.z = cvt_pk_bf16(v1[0], v1[1]); w.w = cvt_pk_bf16(v1[2], v1[3]);
                        if (bj == 0 || boff1 != 0) __builtin_nontemporal_store(w, (u32x4*)(rowp + bj * HALF)); }
            }
        }
    }
};

template <class Epi, class Sched, bool ALIGN_EPI = false, bool SP2 = false>
__device__ __forceinline__ void gemm_phase(PG8_LAS unsigned char* lds, const Gemm g, const Sched& S, const Epi& E) {
    int tid_ = threadIdx.x; asm volatile("" : "+v"(tid_));
    const int tid = tid_, wid = __builtin_amdgcn_readfirstlane(tid >> 6), lane = tid & 63, wr = wid >> 2, wc = wid & 3, fr = lane & 15, fq = lane >> 4;
    const int K = g.K, nt = K / BK;
    unsigned voffA[2], voffB[2];
#pragma unroll
    for (int i = 0; i < 2; ++i) { int R, C; stage_rc(tid * 16 + i * 8192, R, C); const int Rb = E.perm() ? ((R & ~31) + perm32(R & 31)) : R;
        voffA[i] = (unsigned)(R * g.lda + C) * 2u; voffB[i] = (unsigned)(Rb * g.ldb + C) * 2u; }
    const size_t kstep = (size_t)(BK * 2);
    const size_t hstepA = (size_t)HALF * g.lda * 2, hstepB = (size_t)HALF * g.ldb * 2;
    const size_t tstepA = 2 * hstepA, tstepB = 2 * hstepB;
    const size_t apn = (size_t)g.apn * 2;
    const unsigned ldsw = (unsigned)wid * 1024u;
    const int aoff = lds_byte(wr * 64 + fr, fq * 8), boff = lds_byte(wc * 32 + fr, fq * 8);
#define PG8_SA(b, h) (((b) * 2 + (h)) * HTB)
#define PG8_SB(b, h) ((4 + (b) * 2 + (h)) * HTB)
#define PG8_STAGE(bufoff, gbase, voff) do { _Pragma("unroll") for (int _i = 0; _i < 2; ++_i) \
        __builtin_amdgcn_global_load_lds((const unsigned*)((const char*)(gbase) + (voff)[_i]), (PG8_LAS unsigned*)(lds + (bufoff) + ldsw + _i * 8192), 16, 0, 0); } while (0)
#define PG8_LDA(dst, b, h) do { _Pragma("unroll") for (int m = 0; m < 4; ++m) _Pragma("unroll") for (int k = 0; k < 2; ++k) dst[m][k] = *(const PG8_LAS bf16x8*)(lds + PG8_SA(b, h) + aoff + m * 2048 + k * 1024); } while (0)
#define PG8_LDB(dst, b, h) do { _Pragma("unroll") for (int n = 0; n < 2; ++n) _Pragma("unroll") for (int k = 0; k < 2; ++k) dst[n][k] = *(const PG8_LAS bf16x8*)(lds + PG8_SB(b, h) + boff + n * 2048 + k * 1024); } while (0)
#define PG8_MMA(ai, bj, At, Bt) do { __builtin_amdgcn_s_setprio(1); _Pragma("unroll") for (int m = 0; m < 4; ++m) _Pragma("unroll") for (int n = 0; n < 2; ++n) _Pragma("unroll") for (int k = 0; k < 2; ++k) \
        acc[ai][bj][m][n] = __builtin_amdgcn_mfma_f32_16x16x32_bf16(Bt[n][k], At[m][k], acc[ai][bj][m][n], 0, 0, 0); __builtin_amdgcn_s_setprio(0); } while (0)
#define PG8_WAIT_V(n) asm volatile("s_waitcnt vmcnt(" #n ")" ::: "memory")
#define PG8_WAIT_L(n) asm volatile("s_waitcnt lgkmcnt(" #n ")" ::: "memory")
#define PG8_BAR __builtin_amdgcn_s_barrier()
#define PG8_SCHED __builtin_amdgcn_sched_barrier(0)
    Unit cur, nxt; int ui = 0;
    if (!S.next(0, cur)) return;
    f32x4 acc[2][2][4][2];
#pragma unroll
    for (int a = 0; a < 2; ++a)
#pragma unroll
        for (int b = 0; b < 2; ++b)
#pragma unroll
            for (int m = 0; m < 4; ++m)
#pragma unroll
                for (int n = 0; n < 2; ++n) acc[a][b][m][n] = (f32x4){0.f, 0.f, 0.f, 0.f};
    bf16x8 At[4][2], B0[2][2], B1[2][2];
    const char* cA = (const char*)g.A + (size_t)cur.pm * tstepA + (size_t)cur.pn * apn; const char* cB = (const char*)g.Bt + (size_t)cur.pn * tstepB;
    S.a_ready(cur);
    if constexpr (SP2) {
        PG8_STAGE(PG8_SB(0, 0), cB, voffB); PG8_STAGE(PG8_SB(0, 1), cB + hstepB, voffB); PG8_STAGE(PG8_SA(0, 0), cA, voffA); PG8_STAGE(PG8_SA(0, 1), cA + hstepA, voffA);
        if (wr == 1) PG8_BAR;
        PG8_WAIT_V(2); PG8_BAR;
        PG8_STAGE(PG8_SB(1, 0), cB + kstep, voffB); PG8_STAGE(PG8_SA(1, 0), cA + kstep, voffA); PG8_STAGE(PG8_SB(1, 1), cB + hstepB + kstep, voffB);
        PG8_WAIT_V(6); PG8_BAR;
    } else {
        PG8_STAGE(PG8_SB(0, 0), cB, voffB); PG8_STAGE(PG8_SA(0, 0), cA, voffA); PG8_STAGE(PG8_SB(0, 1), cB + hstepB, voffB); PG8_STAGE(PG8_SA(0, 1), cA + hstepA, voffA);
        if (wr == 1) PG8_BAR;
        PG8_WAIT_V(4); PG8_BAR;
        PG8_STAGE(PG8_SB(1, 0), cB + kstep, voffB); PG8_STAGE(PG8_SA(1, 0), cA + kstep, voffA); PG8_STAGE(PG8_SB(1, 1), cB + hstepB + kstep, voffB);
        PG8_WAIT_V(6); PG8_BAR;
    }
    for (;;) {
        const bool has_next = S.next(ui + 1, nxt);
        const char* nA = has_next ? (const char*)g.A + (size_t)nxt.pm * tstepA + (size_t)nxt.pn * apn : cA; const char* nB = has_next ? (const char*)g.Bt + (size_t)nxt.pn * tstepB : cB;
        for (int t = 0; t < nt; t += 2) {
            const bool last = (t == nt - 2);
            const char* a1 = cA + (size_t)(t + 1) * kstep;
            const char* a2 = last ? nA : cA + (size_t)(t + 2) * kstep; const char* b2 = last ? nB : cB + (size_t)(t + 2) * kstep;
            const char* a3 = a2 + kstep; const char* b3 = b2 + kstep;
            if (last && has_next) S.a_ready(nxt);
            if constexpr (SP2) {
            PG8_LDB(B0, 0, 0); PG8_LDB(B1, 0, 1); PG8_SCHED; PG8_LDA(At, 0, 0); PG8_STAGE(PG8_SA(1, 1), a1 + hstepA, voffA);
            PG8_WAIT_V(8); PG8_WAIT_L(0); PG8_BAR; PG8_MMA(0, 0, At, B0); PG8_MMA(0, 1, At, B1); PG8_BAR; PG8_SCHED;
            PG8_LDA(At, 0, 1); PG8_STAGE(PG8_SB(0, 0), b2, voffB); PG8_STAGE(PG8_SB(0, 1), b2 + hstepB, voffB); PG8_STAGE(PG8_SA(0, 0), a2, voffA);
            PG8_WAIT_V(8); PG8_WAIT_L(0); PG8_BAR; PG8_MMA(1, 0, At, B0); PG8_MMA(1, 1, At, B1); PG8_BAR; PG8_SCHED;
            PG8_LDB(B0, 1, 0); PG8_LDB(B1, 1, 1); PG8_SCHED; PG8_LDA(At, 1, 0); PG8_STAGE(PG8_SA(0, 1), a2 + hstepA, voffA);
            PG8_WAIT_V(8); PG8_WAIT_L(0); PG8_BAR; PG8_MMA(0, 0, At, B0); PG8_MMA(0, 1, At, B1); PG8_BAR; PG8_SCHED;
            PG8_LDA(At, 1, 1); PG8_STAGE(PG8_SB(1, 0), b3, voffB); PG8_STAGE(PG8_SB(1, 1), b3 + hstepB, voffB); PG8_STAGE(PG8_SA(1, 0), a3, voffA);
            PG8_WAIT_V(8); PG8_WAIT_L(0); PG8_BAR; PG8_MMA(1, 0, At, B0); PG8_MMA(1, 1, At, B1); PG8_BAR; PG8_SCHED;
            } else {
            PG8_LDB(B0, 0, 0); PG8_SCHED; PG8_LDA(At, 0, 0); PG8_STAGE(PG8_SA(1, 1), a1 + hstepA, voffA);
            PG8_WAIT_L(8); PG8_BAR; PG8_WAIT_L(0); PG8_MMA(0, 0, At, B0); PG8_BAR; PG8_SCHED;
            PG8_LDB(B1, 0, 1); PG8_STAGE(PG8_SB(0, 0), b2, voffB);
            PG8_BAR; PG8_WAIT_L(0); PG8_MMA(0, 1, At, B1); PG8_BAR;
            PG8_LDA(At, 0, 1); PG8_STAGE(PG8_SA(0, 0), a2, voffA);
            PG8_BAR; PG8_WAIT_L(0); PG8_MMA(1, 0, At, B0); PG8_BAR; PG8_SCHED;
            PG8_STAGE(PG8_SB(0, 1), b2 + hstepB, voffB);
            PG8_WAIT_V(6); PG8_BAR; PG8_MMA(1, 1, At, B1); PG8_BAR;
            PG8_LDB(B0, 1, 0); PG8_SCHED; PG8_LDA(At, 1, 0); PG8_STAGE(PG8_SA(0, 1), a2 + hstepA, voffA);
            PG8_WAIT_L(8); PG8_BAR; PG8_WAIT_L(0); PG8_MMA(0, 0, At, B0); PG8_BAR; PG8_SCHED;
            PG8_LDB(B1, 1, 1); PG8_STAGE(PG8_SB(1, 0), b3, voffB);
            PG8_BAR; PG8_WAIT_L(0); PG8_MMA(0, 1, At, B1); PG8_BAR;
            PG8_LDA(At, 1, 1); PG8_STAGE(PG8_SA(1, 0), a3, voffA);
            PG8_BAR; PG8_WAIT_L(0); PG8_MMA(1, 0, At, B0); PG8_BAR; PG8_SCHED;
            PG8_STAGE(PG8_SB(1, 1), b3 + hstepB, voffB);
            PG8_WAIT_V(6); PG8_BAR; PG8_MMA(1, 1, At, B1); PG8_BAR;
            }
        }
        if constexpr (ALIGN_EPI) { if (wr == 0) PG8_BAR; }
        cur.boff1 = HALF;
        if (E.mode == 0 && cur.pn >= E.zpn0) {
            cur.boff1 = 0;
#pragma unroll
            for (int a = 0; a < 2; ++a)
#pragma unroll
                for (int m = 0; m < 4; ++m)
#pragma unroll
                    for (int n = 0; n < 2; ++n) { acc[a][0][m][n] = acc[a][0][m][n] * acc[a][1][m][n]; }
        }
        if constexpr (!Epi::AFTER_DRAIN) { E(acc, cur, wr, wc, fr, fq); S.done(cur, ui); }
        if (!has_next) break;
#pragma unroll
        for (int a = 0; a < 2; ++a)
#pragma unroll
            for (int b = 0; b < 2; ++b)
#pragma unroll
                for (int m = 0; m < 4; ++m)
#pragma unroll
                    for (int n = 0; n < 2; ++n) acc[a][b][m][n] = (f32x4){0.f, 0.f, 0.f, 0.f};
        cur = nxt; cA = nA; cB = nB; ++ui;
        if constexpr (ALIGN_EPI) { if (wr == 1) PG8_BAR; }
    }
    PG8_WAIT_V(0);
    if constexpr (!ALIGN_EPI) { if (wr == 0) PG8_BAR; }
    PG8_BAR;
#undef PG8_SA
#undef PG8_SB
#undef PG8_STAGE
#undef PG8_LDA
#undef PG8_LDB
#undef PG8_MMA
#undef PG8_WAIT_V
#undef PG8_WAIT_L
#undef PG8_BAR
#undef PG8_SCHED
}
}

#ifndef PG8_SP2
#define PG8_SP2 true
#endif
#ifndef PG8_ALIGN
#define PG8_ALIGN true
#endif

#define LAS __attribute__((address_space(3)))
typedef unsigned short bf16;
typedef unsigned v4u __attribute__((ext_vector_type(4)));
typedef unsigned v2u __attribute__((ext_vector_type(2)));
typedef float f32x4 __attribute__((ext_vector_type(4)));
#define LDS_WAIT() asm volatile("s_waitcnt lgkmcnt(0)" ::: "memory")
__device__ __forceinline__ unsigned pk2(float lo, float hi) { return pg8::cvt_pk_bf16(lo, hi); }
__device__ __forceinline__ float wave_sum(float v) {
#pragma unroll
    for (int o = 1; o < 64; o <<= 1) v += __shfl_xor(v, o);
    return v;
}
struct F8 { f32x4 a, b; };
__device__ __forceinline__ float bflo(unsigned u) { return __uint_as_float(u << 16); }
__device__ __forceinline__ float bfhi(unsigned u) { return __uint_as_float(u & 0xffff0000u); }
__device__ __forceinline__ F8 ld_bf8(const bf16* p) { const v4u w = *(const v4u*)p; F8 r; r.a = (f32x4){bflo(w.x), bfhi(w.x), bflo(w.y), bfhi(w.y)}; r.b = (f32x4){bflo(w.z), bfhi(w.z), bflo(w.w), bfhi(w.w)}; return r; }
__device__ __forceinline__ F8 ld_f8(const float* p) { F8 r; r.a = *(const f32x4*)p; r.b = *(const f32x4*)(p + 4); return r; }
__device__ __forceinline__ void st_bf8(bf16* p, const F8& v) { v4u w; w.x = pk2(v.a.x, v.a.y); w.y = pk2(v.a.z, v.a.w); w.z = pk2(v.b.x, v.b.y); w.w = pk2(v.b.z, v.b.w); *(v4u*)p = w; }
__device__ __forceinline__ void st_f8(float* p, const F8& v) { *(f32x4*)p = v.a; *(f32x4*)(p + 4) = v.b; }

__device__ __forceinline__ void p0_transpose_item(const float* W, int K, int N, bf16* WT, int row_off, LAS float* scr, int item, int lane, bool zperm = false, const float* kscale = nullptr, const float* nscale = nullptr) {
    const int nblk = N / 32, kb = item / nblk, nb = item % nblk, k0 = 64 * kb, n0 = 32 * nb;
    const int ns = (zperm && n0 >= 2 * PW) ? ((((n0 & 255) < 128) ? 2 * PW : 2 * PW + CW - 128) + 128 * ((n0 >> 8) - 8) + (n0 & 255)) : n0;
    const int l7 = lane & 7, l8 = lane >> 3;
    f32x4 v[8];
#pragma unroll
    for (int i = 0; i < 8; ++i) v[i] = __builtin_nontemporal_load((const f32x4*)(W + (size_t)(k0 + l8 + 8 * i) * N + ns + 4 * l7));
    if (kscale) {
#pragma unroll
        for (int i = 0; i < 8; ++i) v[i] = v[i] * kscale[k0 + l8 + 8 * i];
    }
    if (nscale) { const f32x4 sn = *(const f32x4*)(nscale + n0 + 4 * l7);
#pragma unroll
        for (int i = 0; i < 8; ++i) v[i] = v[i] * sn;
    }
#pragma unroll
    for (int i = 0; i < 8; ++i) { LAS float* d = scr + (l8 + 8 * i) * 33 + 4 * l7; d[0] = v[i].x; d[1] = v[i].y; d[2] = v[i].z; d[3] = v[i].w; }
    LDS_WAIT(); asm volatile("" ::: "memory");
    const int c = lane & 7;
#pragma unroll
    for (int j = 0; j < 4; ++j) { const int n = (lane >> 3) + 8 * j; const LAS float* s = scr + (8 * c) * 33 + n;
        v4u o; o.x = pk2(s[0 * 33], s[1 * 33]); o.y = pk2(s[2 * 33], s[3 * 33]); o.z = pk2(s[4 * 33], s[5 * 33]); o.w = pk2(s[6 * 33], s[7 * 33]);
        *(v4u*)(WT + (size_t)(row_off + n0 + n) * K + k0 + 8 * c) = o; }
    LDS_WAIT(); asm volatile("" ::: "memory");
}
__device__ __forceinline__ void rms_rows2_bf16(const float* x0, const float* x1, bool has1, const float* g, bf16* o0, bf16* o1, int lane) {
    const f32x4* xr0 = (const f32x4*)x0 + lane; const f32x4* xr1 = (const f32x4*)x1 + lane;
    f32x4 v[8], w[8]; float s0 = 0.f, s1 = 0.f;
#pragma unroll
    for (int j = 0; j < 8; ++j) v[j] = __builtin_nontemporal_load(xr0 + 64 * j);
    if (has1) {
#pragma unroll
        for (int j = 0; j < 8; ++j) w[j] = __builtin_nontemporal_load(xr1 + 64 * j);
    } else {
#pragma unroll
        for (int j = 0; j < 8; ++j) w[j] = (f32x4){0.f, 0.f, 0.f, 0.f};
    }
#pragma unroll
    for (int j = 0; j < 8; ++j) { s0 += (v[j].x * v[j].x + v[j].y * v[j].y) + (v[j].z * v[j].z + v[j].w * v[j].w); s1 += (w[j].x * w[j].x + w[j].y * w[j].y) + (w[j].z * w[j].z + w[j].w * w[j].w); }
    const float r0 = 1.f / sqrtf(wave_sum(s0) * (1.f / D) + EPS), r1 = 1.f / sqrtf(wave_sum(s1) * (1.f / D) + EPS);
    const f32x4* gr = (const f32x4*)g + lane;
    v2u* p0 = (v2u*)o0 + lane; v2u* p1 = (v2u*)o1 + lane;
#pragma unroll
    for (int j = 0; j < 8; ++j) { const f32x4 gv = gr[64 * j]; const f32x4 a = v[j] * r0 * gv; v2u q; q.x = pk2(a.x, a.y); q.y = pk2(a.z, a.w); p0[64 * j] = q;
        if (has1) { const f32x4 b = w[j] * r1 * gv; v2u q1; q1.x = pk2(b.x, b.y); q1.y = pk2(b.z, b.w); p1[64 * j] = q1; } }
}
__device__ __forceinline__ void rms_rows2_f32_inplace(float* x0, float* x1, bool has1, const float* g, int lane) {
    f32x4* xr0 = (f32x4*)x0 + lane; f32x4* xr1 = (f32x4*)x1 + lane;
    f32x4 v[8], w[8]; float s0 = 0.f, s1 = 0.f;
#pragma unroll
    for (int j = 0; j < 8; ++j) v[j] = xr0[64 * j];
    if (has1) {
#pragma unroll
        for (int j = 0; j < 8; ++j) w[j] = xr1[64 * j];
    } else {
#pragma unroll
        for (int j = 0; j < 8; ++j) w[j] = (f32x4){0.f, 0.f, 0.f, 0.f};
    }
#pragma unroll
    for (int j = 0; j < 8; ++j) { s0 += (v[j].x * v[j].x + v[j].y * v[j].y) + (v[j].z * v[j].z + v[j].w * v[j].w); s1 += (w[j].x * w[j].x + w[j].y * w[j].y) + (w[j].z * w[j].z + w[j].w * w[j].w); }
    const float r0 = 1.f / sqrtf(wave_sum(s0) * (1.f / D) + EPS), r1 = 1.f / sqrtf(wave_sum(s1) * (1.f / D) + EPS);
    const f32x4* gr = (const f32x4*)g + lane;
#pragma unroll
    for (int j = 0; j < 8; ++j) { const f32x4 gv = gr[64 * j]; xr0[64 * j] = v[j] * r0 * gv; if (has1) xr1[64 * j] = w[j] * r1 * gv; }
}

__device__ __forceinline__ F8 cvt_bf8(const v4u w) { F8 r; r.a = (f32x4){bflo(w.x), bfhi(w.x), bflo(w.y), bfhi(w.y)}; r.b = (f32x4){bflo(w.z), bfhi(w.z), bflo(w.w), bfhi(w.w)}; return r; }
__device__ __forceinline__ void rms_rows2_bf16_to_f32(const bf16* h0, const bf16* h1, bool has1, const float* g, float* o0, float* o1, int lane) {
    const v4u* r0 = (const v4u*)h0 + lane; const v4u* r1 = (const v4u*)h1 + lane;
    v4u a[4], b[4];
#pragma unroll
    for (int j = 0; j < 4; ++j) a[j] = __builtin_nontemporal_load(r0 + 64 * j);
    if (has1) {
#pragma unroll
        for (int j = 0; j < 4; ++j) b[j] = __builtin_nontemporal_load(r1 + 64 * j);
    } else {
#pragma unroll
        for (int j = 0; j < 4; ++j) b[j] = (v4u){0u, 0u, 0u, 0u};
    }
    F8 v[4], w[4]; float s0 = 0.f, s1 = 0.f;
#pragma unroll
    for (int j = 0; j < 4; ++j) { v[j] = cvt_bf8(a[j]); w[j] = cvt_bf8(b[j]);
        const f32x4 q0 = v[j].a * v[j].a + v[j].b * v[j].b, q1 = w[j].a * w[j].a + w[j].b * w[j].b; s0 += (q0.x + q0.y) + (q0.z + q0.w); s1 += (q1.x + q1.y) + (q1.z + q1.w); }
    const float i0 = 1.f / sqrtf(wave_sum(s0) * (1.f / D) + EPS), i1 = 1.f / sqrtf(wave_sum(s1) * (1.f / D) + EPS);
#pragma unroll
    for (int j = 0; j < 4; ++j) { const f32x4 ga = *((const f32x4*)g + 2 * (lane + 64 * j)), gb = *((const f32x4*)g + 2 * (lane + 64 * j) + 1);
        f32x4* p0 = (f32x4*)o0 + 2 * (lane + 64 * j); __builtin_nontemporal_store(v[j].a * i0 * ga, p0); __builtin_nontemporal_store(v[j].b * i0 * gb, p0 + 1);
        if (has1) { f32x4* p1 = (f32x4*)o1 + 2 * (lane + 64 * j); __builtin_nontemporal_store(w[j].a * i1 * ga, p1); __builtin_nontemporal_store(w[j].b * i1 * gb, p1 + 1); } }
}

__device__ __forceinline__ void mixer_item_generic(int j, int c, const bf16* PROJ, const float* cache_pool, const float* cache_conv, const float* conv_w, bf16* DMAT, bf16* MIX, float* out) {
    const bool samp = j >= MPO; int b, t; size_t prow;
    if (!samp) { b = j >> 11; t = j & 2047; prow = (size_t)b * LP + NMETA + t; }
    else { const int s = j - MPO; b = s >> 5; t = s & 31; prow = (size_t)MP + s; }
    if (c < 128) {
        const int ch = c * 8, w = 2 << (c >> 5);
        const bf16* base = PROJ + prow * LDP + ch;
        const F8 u = ld_bf8(base); F8 sum = u;
        for (int k = 1; k < w; ++k) {
            F8 e;
            if (!samp || t - k >= 0) e = ld_bf8(base - (size_t)k * LDP);
            else e = ld_f8(cache_pool + ((size_t)b * 15 + (15 + t - k)) * PW + ch);
            sum.a += e.a; sum.b += e.b;
        }
        const float inv = 1.f / (float)w;
        F8 d; d.a = sum.a * inv - u.a; d.b = sum.b * inv - u.b;
        st_bf8(DMAT + (size_t)j * PW + ch, d);
        if (!samp) { if (t >= SEQ - 15) st_f8(out + O_SPP + ((size_t)b * 15 + (t - (SEQ - 15))) * PW + ch, u); }
        else { if (t >= SL - 15) st_f8(out + O_SPS + ((size_t)b * 15 + (t - (SL - 15))) * PW + ch, u); }
    } else {
        const int ch = (c - 128) * 8;
        const bf16* base = PROJ + prow * LDP + ch;
        const F8 bg = ld_bf8(base + PW), z0 = ld_bf8(base + ZOFF(ch));
        F8 z1, z2;
        if (!samp || t >= 1) z1 = ld_bf8(base - LDP + ZOFF(ch)); else z1 = ld_f8(cache_conv + ((size_t)b * 2 + 1) * CW + ch);
        if (!samp || t >= 2) z2 = ld_bf8(base - 2 * (size_t)LDP + ZOFF(ch)); else z2 = ld_f8(cache_conv + ((size_t)b * 2 + t) * CW + ch);
        const F8 w0 = ld_f8(conv_w + ch), w1 = ld_f8(conv_w + CW + ch), w2 = ld_f8(conv_w + 2 * CW + ch);
        F8 y; y.a = bg.a * (z2.a * w0.a + z1.a * w1.a + z0.a * w2.a); y.b = bg.b * (z2.b * w0.b + z1.b * w1.b + z0.b * w2.b);
        st_bf8(MIX + (size_t)j * D + PW + ch, y);
        if (!samp) { if (t >= SEQ - 2) st_f8(out + O_SCP + ((size_t)b * 2 + (t - (SEQ - 2))) * CW + ch, z0); }
        else { if (t >= SL - 2) st_f8(out + O_SCS + ((size_t)b * 2 + (t - (SL - 2))) * CW + ch, z0); }
    }
}
template <int W> __device__ __forceinline__ void pool_rows4_prompt(const bf16* PROJ, bf16* DMAT, float* out, int j0, int ch) {
    const int b = j0 >> 11, t0 = j0 & 2047;
    const bf16* base = PROJ + ((size_t)b * LP + NMETA + t0 + 3) * LDP + ch;
    v4u raw[W + 3];
#pragma unroll
    for (int k = 0; k < W + 3; ++k) raw[k] = *(const v4u*)(base - (size_t)k * LDP);
    F8 S = cvt_bf8(raw[3]);
#pragma unroll
    for (int k = 4; k < W + 3; ++k) { const F8 e = cvt_bf8(raw[k]); S.a += e.a; S.b += e.b; }
    const float inv = 1.f / (float)W;
#pragma unroll
    for (int i = 0; i < 4; ++i) {
        const F8 u = cvt_bf8(raw[3 - i]);
        if (i > 0) { const F8 o = cvt_bf8(raw[W + 3 - i]); S.a += u.a - o.a; S.b += u.b - o.b; }
        F8 d; d.a = S.a * inv - u.a; d.b = S.b * inv - u.b;
        st_bf8(DMAT + (size_t)(j0 + i) * PW + ch, d);
        if (t0 + i >= SEQ - 15) st_f8(out + O_SPP + ((size_t)b * 15 + (t0 + i - (SEQ - 15))) * PW + ch, u);
    }
}
__device__ __forceinline__ void conv_rows4_prompt(const bf16* PROJ, const float* conv_w, bf16* MIX, float* out, int j0, int ch) {
    const int b = j0 >> 11, t0 = j0 & 2047;
    const bf16* base = PROJ + ((size_t)b * LP + NMETA + t0) * LDP + ch;
    v4u rz[6], rb[4];
#pragma unroll
    for (int k = 0; k < 6; ++k) rz[k] = *(const v4u*)(base + (ptrdiff_t)(k - 2) * LDP + ZOFF(ch));
#pragma unroll
    for (int i = 0; i < 4; ++i) rb[i] = *(const v4u*)(base + (size_t)i * LDP + PW);
    const F8 w0 = ld_f8(conv_w + ch), w1 = ld_f8(conv_w + CW + ch), w2 = ld_f8(conv_w + 2 * CW + ch);
    F8 z[6];
#pragma unroll
    for (int k = 0; k < 6; ++k) z[k] = cvt_bf8(rz[k]);
#pragma unroll
    for (int i = 0; i < 4; ++i) {
        const F8 bg = cvt_bf8(rb[i]);
        F8 y; y.a = bg.a * (z[i].a * w0.a + z[i + 1].a * w1.a + z[i + 2].a * w2.a); y.b = bg.b * (z[i].b * w0.b + z[i + 1].b * w1.b + z[i + 2].b * w2.b);
        st_bf8(MIX + (size_t)(j0 + i) * D + PW + ch, y);
        if (t0 + i >= SEQ - 2) st_f8(out + O_SCP + ((size_t)b * 2 + (t0 + i - (SEQ - 2))) * CW + ch, z[i + 2]);
    }
}

#define XB_TMO      128
#define XB_XCNT(j)  (256  + 64 * (j))
#define XB_XSUB(j)  (1280 + 64 * (j))
#define XB_XGEN(j)  (2304 + 64 * (j))
#define XB_TOP      3328
#define XB_TOPGEN   3392
#define XCD_BAR_WORDS 3456
#define XB_SPIN_CAP (1u << 20)
__device__ __forceinline__ unsigned xb_ld(unsigned* p)              { return __hip_atomic_load(p, __ATOMIC_RELAXED, __HIP_MEMORY_SCOPE_AGENT); }
__device__ __forceinline__ unsigned xb_add(unsigned* p, unsigned v) { return __hip_atomic_fetch_add(p, v, __ATOMIC_RELAXED, __HIP_MEMORY_SCOPE_AGENT); }
__device__ __forceinline__ unsigned xb_xcc_id() { return (unsigned)__builtin_amdgcn_s_getreg((3 << 11) | 20) & 0xFu; }
#define XB_SPIN(cond, bar) do { unsigned _sp = 0; while (cond) { __builtin_amdgcn_s_sleep(1); \
    if ((++_sp & 255u) == 0u) { if (xb_ld(&(bar)[XB_TMO])) break; if (_sp > XB_SPIN_CAP) { atomicAdd(&(bar)[XB_TMO], 1u); break; } } } } while (0)
__device__ __forceinline__ void xcd_barrier_post(unsigned* bar) { if (threadIdx.x == 0) (void)xb_add(&bar[XB_XCNT(xb_xcc_id())], 1u); }
__device__ __forceinline__ void xcd_barrier_complete(unsigned* bar, unsigned x, unsigned& nloc, unsigned& nx) {
    const unsigned G = gridDim.x * gridDim.y * gridDim.z;
    unsigned sum, cnt, mine, sp = 0u;
    for (;;) {
        sum = 0u; cnt = 0u; mine = 0u;
#pragma unroll
        for (unsigned j = 0; j < 16; ++j) { const unsigned c = xb_ld(&bar[XB_XCNT(j)]); sum += c; cnt += (c > 0u) ? 1u : 0u; mine = (j == x) ? c : mine; }
        if (sum == G) break;
        __builtin_amdgcn_s_sleep(1);
        if ((++sp & 255u) == 0u) { if (xb_ld(&bar[XB_TMO])) break; if (sp > XB_SPIN_CAP) { atomicAdd(&bar[XB_TMO], 1u); break; } }
    }
    nloc = mine > 0u ? mine : 1u; nx = cnt > 0u ? cnt : 1u;
}
__device__ __forceinline__ void xcd_barrier(unsigned* bar, volatile LAS unsigned* st) {
    asm volatile("s_waitcnt vmcnt(0)" ::: "memory");
    __syncthreads();
    if (threadIdx.x == 0) {
        const unsigned x = xb_xcc_id();
        __builtin_amdgcn_s_waitcnt(0);
        unsigned nloc = st[0], nx = st[1];
        if (nloc == 0u) { xcd_barrier_complete(bar, x, nloc, nx); st[0] = nloc; st[1] = nx; }
        const unsigned old = xb_add(&bar[XB_XSUB(x)], 1u);
        const unsigned gen = old / nloc;
        if (old + 1u == (gen + 1u) * nloc) {
            __builtin_amdgcn_fence(__ATOMIC_RELEASE, "agent");
            asm volatile("s_waitcnt vmcnt(0)" ::: "memory");
            const unsigned og = xb_add(&bar[XB_TOP], 1u);
            const unsigned tg = og / nx;
            if (og + 1u == (tg + 1u) * nx) xb_add(&bar[XB_TOPGEN], 1u);
            else XB_SPIN(xb_ld(&bar[XB_TOPGEN]) == tg, bar);
            __builtin_amdgcn_fence(__ATOMIC_ACQUIRE, "agent");
            xb_add(&bar[XB_XGEN(x)], 1u);
            asm volatile("s_waitcnt vmcnt(0)" ::: "memory");
        } else {
            XB_SPIN(xb_ld(&bar[XB_XGEN(x)]) == gen, bar);
            __builtin_amdgcn_fence(__ATOMIC_ACQUIRE, "agent");
            asm volatile("s_waitcnt vmcnt(0)" ::: "memory");
        }
    }
    __syncthreads();
}

struct Args { const float* in[15]; float* out; unsigned char* ws; };

__global__ void __launch_bounds__(512, 2) mega_fwd(Args args) {
    extern __shared__ __attribute__((aligned(16))) unsigned char lds_raw[];
    cg::grid_group grid = cg::this_grid();
    LAS unsigned char* lds = (LAS unsigned char*)lds_raw;
    const int G = gridDim.x, bx = blockIdx.x, NGW = G * 8;
    if (threadIdx.x < 2) ((volatile LAS unsigned*)(lds + 131072 + 64))[threadIdx.x] = 0u;
    __syncthreads();
    xcd_barrier_post((unsigned*)(args.ws + WS_CTL));
#define GRID_BAR() xcd_barrier((unsigned*)(args.ws + WS_CTL), (volatile LAS unsigned*)(lds + 131072 + 64))
    unsigned char* ws = args.ws;
    const float* xp = args.in[0]; const float* xs = args.in[1]; const float* cache_pool = args.in[2]; const float* cache_conv = args.in[3];
    const float* meta = args.in[4]; const float* norm1_g = args.in[5]; const float* w_in = args.in[6]; const float* w_pool = args.in[7];
    const float* pool_scale = args.in[8]; const float* conv_w = args.in[9]; const float* w_out = args.in[10]; const float* norm2_g = args.in[11];
    const float* w_up = args.in[12]; const float* w_down = args.in[13]; const float* final_g = args.in[14];
    float* out = args.out;
    bf16* WIN = (bf16*)(ws + WS_WIN); bf16* WOUT = (bf16*)(ws + WS_WOUT); bf16* WUP = (bf16*)(ws + WS_WUP); bf16* WDOWN = (bf16*)(ws + WS_WDOWN); bf16* WPOOL = (bf16*)(ws + WS_WPOOL);
    bf16* HN = (bf16*)(ws + WS_HN); bf16* PROJ = (bf16*)(ws + WS_PROJ); bf16* DMAT = (bf16*)(ws + WS_DMAT); bf16* MIX = (bf16*)(ws + WS_MIX); bf16* ACT = (bf16*)(ws + WS_BIG);

    {
        int tid0 = threadIdx.x; asm volatile("" : "+v"(tid0)); const int lane = tid0 & 63, wave = __builtin_amdgcn_readfirstlane(tid0 >> 6), gw = bx * 8 + wave;
        LAS float* scr = (LAS float*)(lds + wave * 16384);
        constexpr int I_IN = (D / 64) * (INW / 32), I_OUT = (D / 64) * (D / 32), I_PG = (PGC / 64) * (PGC / 32);
        constexpr int NITEMS = I_IN + I_OUT + 4 * I_PG;
        for (int i = bx * 512 + tid0; i < M2; i += G * 512) ((float*)(ws + WS_SSQ))[i] = 0.f;
        for (int it = gw; it < NITEMS; it += NGW) {
            int r = it;
            if (r < I_IN) { p0_transpose_item(w_in, D, INW, WIN, 0, scr, r, lane, true); continue; } r -= I_IN;
            if (r < I_OUT) { p0_transpose_item(w_out, D, D, WOUT, 0, scr, r, lane); continue; } r -= I_OUT;
            const int gq = r / I_PG; r -= gq * I_PG;
            p0_transpose_item(w_pool + (size_t)gq * PGC * PGC, PGC, PGC, WPOOL, gq * PGC, scr, r, lane, false, nullptr, pool_scale + gq * PGC);
        }
        for (int p = gw; p < M1; p += 2 * NGW) {
            const int p1 = p + NGW; const bool has1 = p1 < M1; const int pc = has1 ? p1 : p;
            const float* xr0; const float* xr1;
            if (p < MP) { const int b = p / LP, pos = p - b * LP; xr0 = pos < NMETA ? meta + (size_t)pos * D : xp + ((size_t)b * SEQ + (pos - NMETA)) * D; }
            else xr0 = xs + (size_t)(p - MP) * D;
            if (pc < MP) { const int b = pc / LP, pos = pc - b * LP; xr1 = pos < NMETA ? meta + (size_t)pos * D : xp + ((size_t)b * SEQ + (pos - NMETA)) * D; }
            else xr1 = xs + (size_t)(pc - MP) * D;
            rms_rows2_bf16(xr0, xr1, has1, norm1_g, HN + (size_t)p * D, HN + (size_t)pc * D, lane);
        }
    }
    GRID_BAR();
    if (out == nullptr) grid.sync();

    const bool ov = (G == 256);
    unsigned* sig2 = (unsigned*)(ws + WS_CTL) + 6144;
    unsigned* sigT = (unsigned*)(ws + WS_CTL) + 7680;
    for (int st = 0; st < 6; ++st) {
        if (st == 4 && !ov) continue;
        const int gi = st < 4 ? st : st - 1;
        if (gi == 1) {
            {
                int tid2 = threadIdx.x; asm volatile("" : "+v"(tid2));
                const int lane = tid2 & 63, gw = bx * 8 + __builtin_amdgcn_readfirstlane(tid2 >> 6), half = lane >> 5, l31 = lane & 31;
                const int cb = gw & 7, vb = ((G & 7) == 0) ? (bx & 7) * (G >> 3) + (bx >> 3) : bx;
                for (int q = vb; q < MPO / 8; q += G) {
                    const int j0 = 8 * q + 4 * half;
                    if (cb == 0) pool_rows4_prompt<2>(PROJ, DMAT, out, j0, l31 * 8);
                    else if (cb == 1) pool_rows4_prompt<4>(PROJ, DMAT, out, j0, (32 + l31) * 8);
                    else if (cb == 2) pool_rows4_prompt<8>(PROJ, DMAT, out, j0, (64 + l31) * 8);
                    else if (cb == 3) pool_rows4_prompt<16>(PROJ, DMAT, out, j0, (96 + l31) * 8);
                    else conv_rows4_prompt(PROJ, conv_w, MIX, out, j0, ((cb - 4) * 32 + l31) * 8);
                }
                for (int rp = vb; rp < MS / 2; rp += G) mixer_item_generic(MPO + 2 * rp + half, cb * 32 + l31, PROJ, cache_pool, cache_conv, conv_w, DMAT, MIX, out);
            }

            GRID_BAR();
        }
        pg8::Gemm g; pg8::EpiAny E;
        E.scale = pool_scale; E.xp = xp; E.xs = xs; E.out = out; E.O = PROJ; E.ldc = LDP; E.mode = 0; E.ssq = (float*)(ws + WS_SSQ); E.zpn0 = (gi == 0) ? 2 * PW / 256 : (1 << 30);
        switch (gi) {
        case 0:  g = pg8::Gemm{HN, WIN, M1, INW, D, D, D, 0}; break;
        case 1:  g = pg8::Gemm{DMAT, WPOOL, M2, PW, PGC, PW, PGC, PGC}; E.mode = 0; E.O = MIX; E.ldc = D; break;
        case 2:  g = pg8::Gemm{MIX, WOUT, M2, D, D, D, D, 0}; E.mode = 4; E.O = HN; E.ldc = D; break;
        case 3:  g = pg8::Gemm{HN, WUP, M2, FF, D, D, D, 0}; E.mode = 1; E.O = ACT; E.ldc = FF; break;
        default: g = pg8::Gemm{ACT, WDOWN, M2, D, FF, FF, FF, 0}; E.mode = 5; E.O = HN; E.ldc = D; break;
        }
        const bool tail4 = (gi == 4 && G == 256), tail2 = (gi == 2 && ov);
        unsigned* sig = (unsigned*)(ws + WS_CTL) + 4096;
        pg8::StaticOrder S;
        volatile LAS unsigned* bst = (volatile LAS unsigned*)(lds + 131072 + 64);
        const int wgm = (gi == 0) ? 8 : ((gi == 3) ? WGM_A : WGM_B);
        if (tail4) S.init(MPO, g.N, G, bx, wgm, (M2 - MPO) / 256, sig, 3, bst[0]);
        else if (tail2) S.init(MPO, g.N, G, bx, wgm, (M2 - MPO) / 256, sig2, 3, bst[0]);
        else if (st == 3 && ov) S.init(MPO, g.N, G, bx, wgm);
        else if (st == 4) {
            if (bx >= 128 && threadIdx.x == 0) { unsigned sp = 0;
                while (__hip_atomic_load(sigT, __ATOMIC_RELAXED, __HIP_MEMORY_SCOPE_AGENT) < 32u) { __builtin_amdgcn_s_sleep(2); if (++sp > (1u << 22)) break; }
                __builtin_amdgcn_fence(__ATOMIC_ACQUIRE, "agent"); asm volatile("s_waitcnt vmcnt(0)" ::: "memory"); }
            __syncthreads();
            S.init(MPO, g.N, G, (bx + 128) & 255, wgm, (M2 - MPO) / 256, nullptr, -1, 0, (MPO / 256) * (FF / 256) / 256);
        }
        else S.init(g.M, g.N, G, bx, wgm);
        pg8::gemm_phase<pg8::EpiAny, pg8::StaticOrder, PG8_ALIGN, PG8_SP2>(lds, g, S, E);
        if (gi == 0) {
            constexpr int I_UP = (D / 64) * (FF / 32), I_DOWN = (FF / 64) * (D / 32);
            const int rem = ((M1 / 256) * (INW / 256)) % G, n_idle = rem ? G - rem : G, ic = rem ? bx - rem : bx;
            if (ic >= 0) {
                int tidb = threadIdx.x; asm volatile("" : "+v"(tidb)); const int lane = tidb & 63, wave = __builtin_amdgcn_readfirstlane(tidb >> 6);
                LAS float* scr = (LAS float*)(lds + wave * 16384);
                for (int it = ic * 8 + wave; it < I_UP + I_DOWN; it += n_idle * 8) {
                    if (it < I_UP) p0_transpose_item(w_up, D, FF, WUP, 0, scr, it, lane, false, norm2_g);
                    else p0_transpose_item(w_down, FF, D, WDOWN, 0, scr, it - I_UP, lane);
                }
            }
        }
        if (tail4 && bx >= S.ntail) {
            if (threadIdx.x == 0) {
                unsigned sp = 0; const unsigned want = bst[1];
                while (__hip_atomic_load(sig, __ATOMIC_RELAXED, __HIP_MEMORY_SCOPE_AGENT) < want) { __builtin_amdgcn_s_sleep(2); if (++sp > (1u << 22)) break; }
                __builtin_amdgcn_fence(__ATOMIC_ACQUIRE, "agent");
                asm volatile("s_waitcnt vmcnt(0)" ::: "memory");
            }
            __syncthreads();
            int tidc = threadIdx.x; asm volatile("" : "+v"(tidc)); const int lane = tidc & 63, iw = (bx - S.ntail) * 8 + __builtin_amdgcn_readfirstlane(tidc >> 6), nw = (G - S.ntail) * 8;
            for (int p = iw; p < MPO; p += 2 * nw) { const int p1 = p + nw; const bool has1 = p1 < MPO; const int pc = has1 ? p1 : p;
                rms_rows2_bf16_to_f32(HN + (size_t)p * D, HN + (size_t)pc * D, has1, final_g, out + (size_t)p * D, out + (size_t)pc * D, lane); }
        }
        if (tail2) {
            if (bx < S.ntail) { asm volatile("s_waitcnt vmcnt(0)" ::: "memory"); __syncthreads();
                if (threadIdx.x == 0) { __builtin_amdgcn_fence(__ATOMIC_RELEASE, "agent"); asm volatile("s_waitcnt vmcnt(0)" ::: "memory"); __hip_atomic_fetch_add(sigT, 1u, __ATOMIC_RELAXED, __HIP_MEMORY_SCOPE_AGENT); } }
            if (threadIdx.x == 0) { unsigned sp = 0; const unsigned want = bst[1];
                while (__hip_atomic_load(sig2, __ATOMIC_RELAXED, __HIP_MEMORY_SCOPE_AGENT) < want) { __builtin_amdgcn_s_sleep(2); if (++sp > (1u << 22)) break; }
                __builtin_amdgcn_fence(__ATOMIC_ACQUIRE, "agent"); asm volatile("s_waitcnt vmcnt(0)" ::: "memory"); }
            __syncthreads();
        }
        else if (st == 3 && ov) { }
        else GRID_BAR();
    }

    int tid8 = threadIdx.x; asm volatile("" : "+v"(tid8)); const int lane = tid8 & 63, gw = bx * 8 + __builtin_amdgcn_readfirstlane(tid8 >> 6);
    for (int p = (G == 256 ? MPO : 0) + gw; p < M2; p += 2 * NGW) { const int p1 = p + NGW; const bool has1 = p1 < M2; const int pc = has1 ? p1 : p;
        rms_rows2_bf16_to_f32(HN + (size_t)p * D, HN + (size_t)pc * D, has1, final_g, out + (size_t)p * D, out + (size_t)pc * D, lane); }
}

extern "C" void kernel_launch(void* const* d_in, const int* in_sizes, int n_in, void* d_out, int out_size, void* d_ws, size_t ws_size, hipStream_t stream) {
    static int grid = 0;
    if (grid == 0) {
        if (n_in != 15 || ws_size < WS_END) { fprintf(stderr, "kernel_launch: unexpected n_in %d / ws_size %zu (need %zu)\n", n_in, ws_size, (size_t)WS_END); grid = -1; return; }
        int dev = 0, cus = 0, per_cu = 0;
        if (hipGetDevice(&dev) != hipSuccess || hipDeviceGetAttribute(&cus, hipDeviceAttributeMultiprocessorCount, dev) != hipSuccess) { grid = -1; return; }
        if (hipFuncSetAttribute((const void*)mega_fwd, hipFuncAttributeMaxDynamicSharedMemorySize, LDS_BYTES) != hipSuccess) { fprintf(stderr, "kernel_launch: hipFuncSetAttribute failed\n"); grid = -1; return; }
        if (hipOccupancyMaxActiveBlocksPerMultiprocessor(&per_cu, (const void*)mega_fwd, 512, LDS_BYTES) != hipSuccess || per_cu < 1) { fprintf(stderr, "kernel_launch: occupancy query says %d\n", per_cu); per_cu = 1; }
        (void)hipGetLastError();
        grid = cus * per_cu;
    }
    if (grid < 0) return;
    if (hipMemsetAsync((char*)d_ws + WS_CTL, 0, 65536, stream) != hipSuccess) { fprintf(stderr, "kernel_launch: memset failed\n"); return; }
    Args a{};
    for (int i = 0; i < 15; ++i) a.in[i] = (const float*)d_in[i];
    a.out = (float*)d_out; a.ws = (unsigned char*)d_ws;
    void* kargs[] = {&a};
    hipError_t e = hipLaunchCooperativeKernel((const void*)mega_fwd, dim3(grid), dim3(512), kargs, LDS_BYTES, stream);
    if (e != hipSuccess) fprintf(stderr, "kernel_launch: cooperative launch failed: %s (grid %d)\n", hipGetErrorString(e), grid);
}
```

```cpp
#include <hip/hip_runtime.h>
#include <hip/hip_cooperative_groups.h>
#include <cstdio>
#include <cstdint>
namespace cg = cooperative_groups;

constexpr int D = 2048, NB = 16, SEQ = 2048, NMETA = 16, LP = SEQ + NMETA, SB = 32, SL = 32;
constexpr int MP = NB * LP;
constexpr int MS = SB * SL;
constexpr int M1 = MP + MS;
constexpr int MPO = NB * SEQ;
constexpr int M2 = MPO + MS;
constexpr int INW = 4096, PW = 1024, CW = 1024, FF = 8192, PGC = 256;
constexpr int LDP = INW;
#define ZOFF(ch) (2 * PW + 128 * ((ch) >> 7))
constexpr float EPS = 1e-6f;
static_assert(M1 % 256 == 0 && M2 % 256 == 0, "row tiles");

constexpr size_t MiB = 1u << 20;
constexpr size_t WS_CTL = 0;
constexpr size_t WS_WIN = 1 * MiB;
constexpr size_t WS_WOUT = 17 * MiB;
constexpr size_t WS_WUP = 25 * MiB;
constexpr size_t WS_WDOWN = 57 * MiB;
constexpr size_t WS_WPOOL = 89 * MiB;
constexpr size_t WS_SSQ = 90 * MiB;
constexpr size_t WS_HN = 91 * MiB;
constexpr size_t WS_BIG = 224 * MiB;
constexpr size_t WS_PROJ = WS_BIG;
constexpr size_t WS_DMAT = WS_BIG + 266 * MiB;
constexpr size_t WS_MIX = WS_BIG + 528 * MiB;
constexpr size_t WS_END = WS_MIX + 132 * MiB;
static_assert(WS_HN + (size_t)M1 * D * 2 <= WS_BIG && WS_PROJ + (size_t)M1 * LDP * 2 <= WS_DMAT && WS_MIX + (size_t)M2 * D * 2 <= WS_END && (size_t)M2 * FF * 2 <= 528 * MiB && WS_DMAT + (size_t)M2 * PW * 2 <= WS_BIG + 528 * MiB, "ws map");

constexpr size_t O_Y = 0;
constexpr size_t O_SPP = (size_t)M2 * D;
constexpr size_t O_SCP = O_SPP + (size_t)NB * 15 * PW;
constexpr size_t O_SPS = O_SCP + (size_t)NB * 2 * CW;
constexpr size_t O_SCS = O_SPS + (size_t)SB * 15 * PW;

#ifndef WGM_A
#define WGM_A 4
#endif
#ifndef WGM_B
#define WGM_B 4
#endif
constexpr int LDS_BYTES = 135168;

namespace pg8 {
#define PG8_LAS __attribute__((address_space(3)))
typedef unsigned short bf16_t;
typedef short bf16x8 __attribute__((ext_vector_type(8)));
typedef float f32x4 __attribute__((ext_vector_type(4)));
typedef unsigned u32x4 __attribute__((ext_vector_type(4)));
constexpr int BM = 256, BK = 64, HALF = 128, HTB = HALF * BK * 2, STAGE_BYTES = 8 * HTB, NXCD = 8;

__host__ __device__ __forceinline__ int lds_byte(int r, int c) { const int st = (r >> 4) * 2 + (c >> 5), rr = r & 15, cc = c & 31, ob = rr * 64 + cc * 2; return st * 1024 + (ob ^ (((ob >> 9) & 1) << 5)); }
__host__ __device__ __forceinline__ void stage_rc(int b, int& R, int& C) { const int st = b / 1024, sb = b % 1024, swz = sb ^ (((sb >> 9) & 1) << 5); R = (st >> 1) * 16 + swz / 64; C = (st & 1) * 32 + (swz % 64) / 2; }
__host__ __device__ __forceinline__ int perm32(int rho) { const int n = rho >> 4, i = rho & 15; return 8 * (i >> 2) + 4 * n + (i & 3); }

struct Unit { int pm, pn, boff1; };
struct Gemm { const bf16_t* A; const bf16_t* Bt; int M, N, K, lda, ldb, apn; };

struct StaticOrder {
    int nM, nN, nwg, G, c, tail_round, ntail, sig_ui, WGM, round0; unsigned* sig; unsigned nloc;
    __host__ __device__ void init(int M, int N, int G_, int c_, int wgm, int tail_panels = 0, unsigned* sig_ = nullptr, int sig_ui_ = -1, unsigned nloc_ = 0, int round0_ = 0) {
        WGM = wgm; round0 = round0_;
        nM = M / BM; nN = N / BM; nwg = nM * nN; G = G_; c = c_; tail_round = tail_panels ? nwg / G : -1; ntail = tail_panels * nN; sig = sig_; sig_ui = sig_ui_; nloc = nloc_; }
    __host__ __device__ bool next(int i_, Unit& u) const {
        const int i = i_ + round0; const bool tl = (i == tail_round);
        const long L = (long)i * G + c; const bool ok = tl ? (c < ntail) : (L < nwg);
        int wgid = (int)(L < nwg ? L : 0); { const int q = nwg / NXCD, r = nwg % NXCD, xcd = wgid % NXCD, off = wgid / NXCD; wgid = (xcd < r ? xcd * (q + 1) : r * (q + 1) + (xcd - r) * q) + off; }
        const int nig = WGM * nN, gid = wgid / nig, fm = gid * WGM, gsz = (nM - fm) < WGM ? (nM - fm) : WGM;
        const int pm = fm + ((wgid % nig) % gsz), pn = (wgid % nig) / gsz;
        u.pm = tl ? nM + c / nN : pm; u.pn = tl ? c % nN : pn;
        return ok;
    }
    __device__ __forceinline__ void a_ready(const Unit&) const {}
    __device__ __forceinline__ void done(const Unit&, int ui) const {
        if (sig != nullptr && ui == sig_ui) {
            asm volatile("s_waitcnt vmcnt(0)" ::: "memory");
            __builtin_amdgcn_s_barrier();
            if (threadIdx.x == 0) {
                const unsigned x = (unsigned)__builtin_amdgcn_s_getreg((3 << 11) | 20) & 0xFu;
                const unsigned old = __hip_atomic_fetch_add(sig + 64 * (1 + x), 1u, __ATOMIC_RELAXED, __HIP_MEMORY_SCOPE_AGENT);
                if (old + 1u == nloc) {
                    __builtin_amdgcn_fence(__ATOMIC_RELEASE, "agent");
                    asm volatile("s_waitcnt vmcnt(0)" ::: "memory");
                    __hip_atomic_fetch_add(sig, 1u, __ATOMIC_RELAXED, __HIP_MEMORY_SCOPE_AGENT);
                }
            }
        }
    }
};

__device__ __forceinline__ unsigned cvt_pk_bf16(float lo, float hi) { unsigned r; asm volatile("v_cvt_pk_bf16_f32 %0, %1, %2" : "=v"(r) : "v"(lo), "v"(hi)); return r; }

struct EpiAny {
    static constexpr bool AFTER_DRAIN = false;
    int mode; bf16_t* O; int ldc; const float* scale; const float* xp; const float* xs; float* out; float* ssq; int zpn0;
    __device__ __forceinline__ bool perm() const { return true; }
    __device__ __forceinline__ void operator()(const f32x4 (&acc)[2][2][4][2], const Unit& u, int wr, int wc, int fr, int fq) const {
        const int row0 = u.pm * BM + wr * 64 + fr, col0 = u.pn * BM + wc * 32 + 8 * fq;
        if (mode == 4) {
            float ss[2][4];
#pragma unroll
            for (int ai = 0; ai < 2; ++ai)
#pragma unroll
                for (int m = 0; m < 4; ++m) ss[ai][m] = 0.f;
#pragma unroll
            for (int bj = 0; bj < 2; ++bj) {
#pragma unroll
                for (int ai = 0; ai < 2; ++ai)
#pragma unroll
                    for (int m = 0; m < 4; ++m) { const int row = row0 + ai * HALF + m * 16;
                        const float* xr = (row < MPO ? xp + (size_t)row * D : xs + (size_t)(row - MPO) * D) + col0 + bj * HALF;
                        const f32x4 h0 = __builtin_nontemporal_load((const f32x4*)xr) + acc[ai][bj][m][0], h1 = __builtin_nontemporal_load((const f32x4*)(xr + 4)) + acc[ai][bj][m][1];
                        ss[ai][m] += ((h0[0] * h0[0] + h0[1] * h0[1]) + (h0[2] * h0[2] + h0[3] * h0[3])) + ((h1[0] * h1[0] + h1[1] * h1[1]) + (h1[2] * h1[2] + h1[3] * h1[3]));
                        u32x4 w; w.x = cvt_pk_bf16(h0[0], h0[1]); w.y = cvt_pk_bf16(h0[2], h0[3]); w.z = cvt_pk_bf16(h1[0], h1[1]); w.w = cvt_pk_bf16(h1[2], h1[3]);
                        *(u32x4*)(O + (size_t)row * ldc + col0 + bj * HALF) = w;
                        if (m & 1) asm volatile("" ::: "memory"); }
            }
#pragma unroll
            for (int ai = 0; ai < 2; ++ai)
#pragma unroll
                for (int m = 0; m < 4; ++m) { float sr = ss[ai][m]; sr += __shfl_xor(sr, 16); sr += __shfl_xor(sr, 32);
                    if (fq == 0) __hip_atomic_fetch_add(ssq + row0 + ai * HALF + m * 16, sr, __ATOMIC_RELAXED, __HIP_MEMORY_SCOPE_AGENT); }
        } else if (mode == 5) {
            float ri[2][4];
#pragma unroll
            for (int ai = 0; ai < 2; ++ai)
#pragma unroll
                for (int m = 0; m < 4; ++m) ri[ai][m] = 1.f / (ssq[row0 + ai * HALF + m * 16] * (1.f / D) + EPS);
#pragma unroll
            for (int bj = 0; bj < 2; ++bj)
#pragma unroll
                for (int ai = 0; ai < 2; ++ai)
#pragma unroll
                    for (int m = 0; m < 4; ++m) { const int row = row0 + ai * HALF + m * 16; const u32x4 hb = *(const u32x4*)(O + (size_t)row * ldc + col0 + bj * HALF);
                        const f32x4 r0 = (f32x4){__uint_as_float(hb.x << 16), __uint_as_float(hb.x & 0xffff0000u), __uint_as_float(hb.y << 16), __uint_as_float(hb.y & 0xffff0000u)};
                        const f32x4 r1 = (f32x4){__uint_as_float(hb.z << 16), __uint_as_float(hb.z & 0xffff0000u), __uint_as_float(hb.w << 16), __uint_as_float(hb.w & 0xffff0000u)};
                        const f32x4 v0 = r0 + acc[ai][bj][m][0] * ri[ai][m], v1 = r1 + acc[ai][bj][m][1] * ri[ai][m];
                        u32x4 w; w.x = cvt_pk_bf16(v0[0], v0[1]); w.y = cvt_pk_bf16(v0[2], v0[3]); w.z = cvt_pk_bf16(v1[0], v1[1]); w.w = cvt_pk_bf16(v1[2], v1[3]);
                        __builtin_nontemporal_store(w, (u32x4*)(O + (size_t)row * ldc + col0 + bj * HALF));
                        if (m & 1) asm volatile("" ::: "memory"); }
        } else {
            const int boff1 = u.boff1;
#pragma unroll
            for (int bj = 0; bj < 2; ++bj) {
                f32x4 sv0 = (f32x4){1.f, 1.f, 1.f, 1.f}, sv1 = sv0;
                if (mode == 2) { sv0 = *(const f32x4*)(scale + col0 + bj * HALF); sv1 = *(const f32x4*)(scale + col0 + bj * HALF + 4); }
#pragma unroll
                for (int ai = 0; ai < 2; ++ai)
#pragma unroll
                    for (int m = 0; m < 4; ++m) { bf16_t* rowp = O + (size_t)(row0 + ai * HALF + m * 16) * ldc + col0;
                        f32x4 v0 = acc[ai][bj][m][0], v1 = acc[ai][bj][m][1];
                        if (mode == 1) {
#pragma unroll
                            for (int j = 0; j < 4; ++j) { const float a = fmaxf(v0[j], 0.f), b = fmaxf(v1[j], 0.f); v0[j] = a * a; v1[j] = b * b; } }
                        if (mode == 2) { v0 = v0 * sv0; v1 = v1 * sv1; }
                        u32x4 w; w.x = cvt_pk_bf16(v0[0], v0[1]); w.y = cvt_pk_bf16(v0[2], v0[3]); w.z = cvt_pk_bf16(v1[0], v1[1]); w.w = cvt_pk_bf16(v1[2], v1[3]);
                        if (bj == 0 || boff1 != 0) __builtin_nontemporal_store(w, (u32x4*)(rowp + bj * HALF)); }
            }
        }
    }
};

template <class Epi, class Sched, bool ALIGN_EPI = false, bool SP2 = false>
__device__ __forceinline__ void gemm_phase(PG8_LAS unsigned char* lds, const Gemm g, const Sched& S, const Epi& E) {
    int tid_ = threadIdx.x; asm volatile("" : "+v"(tid_));
    const int tid = tid_, wid = __builtin_amdgcn_readfirstlane(tid >> 6), lane = tid & 63, wr = wid >> 2, wc = wid & 3, fr = lane & 15, fq = lane >> 4;
    const int K = g.K, nt = K / BK;
    unsigned voffA[2], voffB[2];
#pragma unroll
    for (int i = 0; i < 2; ++i) { int R, C; stage_rc(tid * 16 + i * 8192, R, C); const int Rb = E.perm() ? ((R & ~31) + perm32(R & 31)) : R;
        voffA[i] = (unsigned)(R * g.lda + C) * 2u; voffB[i] = (unsigned)(Rb * g.ldb + C) * 2u; }
    const size_t kstep = (size_t)(BK * 2);
    const size_t hstepA = (size_t)HALF * g.lda * 2, hstepB = (size_t)HALF * g.ldb * 2;
    const size_t tstepA = 2 * hstepA, tstepB = 2 * hstepB;
    const size_t apn = (size_t)g.apn * 2;
    const unsigned ldsw = (unsigned)wid * 1024u;
    const int aoff = lds_byte(wr * 64 + fr, fq * 8), boff = lds_byte(wc * 32 + fr, fq * 8);
#define PG8_SA(b, h) (((b) * 2 + (h)) * HTB)
#define PG8_SB(b, h) ((4 + (b) * 2 + (h)) * HTB)
#define PG8_STAGE(bufoff, gbase, voff) do { _Pragma("unroll") for (int _i = 0; _i < 2; ++_i) \
        __builtin_amdgcn_global_load_lds((const unsigned*)((const char*)(gbase) + (voff)[_i]), (PG8_LAS unsigned*)(lds + (bufoff) + ldsw + _i * 8192), 16, 0, 0); } while (0)
#define PG8_LDA(dst, b, h) do { _Pragma("unroll") for (int m = 0; m < 4; ++m) _Pragma("unroll") for (int k = 0; k < 2; ++k) dst[m][k] = *(const PG8_LAS bf16x8*)(lds + PG8_SA(b, h) + aoff + m * 2048 + k * 1024); } while (0)
#define PG8_LDB(dst, b, h) do { _Pragma("unroll") for (int n = 0; n < 2; ++n) _Pragma("unroll") for (int k = 0; k < 2; ++k) dst[n][k] = *(const PG8_LAS bf16x8*)(lds + PG8_SB(b, h) + boff + n * 2048 + k * 1024); } while (0)
#define PG8_MMA(ai, bj, At, Bt) do { __builtin_amdgcn_s_setprio(1); _Pragma("unroll") for (int m = 0; m < 4; ++m) _Pragma("unroll") for (int n = 0; n < 2; ++n) _Pragma("unroll") for (int k = 0; k < 2; ++k) \
        acc[ai][bj][m][n] = __builtin_amdgcn_mfma_f32_16x16x32_bf16(Bt[n][k], At[m][k], acc[ai][bj][m][n], 0, 0, 0); __builtin_amdgcn_s_setprio(0); } while (0)
#define PG8_WAIT_V(n) asm volatile("s_waitcnt vmcnt(" #n ")" ::: "memory")
#define PG8_WAIT_L(n) asm volatile("s_waitcnt lgkmcnt(" #n ")" ::: "memory")
#define PG8_BAR __builtin_amdgcn_s_barrier()
#define PG8_SCHED __builtin_amdgcn_sched_barrier(0)
    Unit cur, nxt; int ui = 0;
    if (!S.next(0, cur)) return;
    f32x4 acc[2][2][4][2];
#pragma unroll
    for (int a = 0; a < 2; ++a)
#pragma unroll
        for (int b = 0; b < 2; ++b)
#pragma unroll
            for (int m = 0; m < 4; ++m)
#pragma unroll
                for (int n = 0; n < 2; ++n) acc[a][b][m][n] = (f32x4){0.f, 0.f, 0.f, 0.f};
    bf16x8 At[4][2], B0[2][2], B1[2][2];
    const char* cA = (const char*)g.A + (size_t)cur.pm * tstepA + (size_t)cur.pn * apn; const char* cB = (const char*)g.Bt + (size_t)cur.pn * tstepB;
    S.a_ready(cur);
    if constexpr (SP2) {
        PG8_STAGE(PG8_SB(0, 0), cB, voffB); PG8_STAGE(PG8_SB(0, 1), cB + hstepB, voffB); PG8_STAGE(PG8_SA(0, 0), cA, voffA); PG8_STAGE(PG8_SA(0, 1), cA + hstepA, voffA);
        if (wr == 1) PG8_BAR;
        PG8_WAIT_V(2); PG8_BAR;
        PG8_STAGE(PG8_SB(1, 0), cB + kstep, voffB); PG8_STAGE(PG8_SA(1, 0), cA + kstep, voffA); PG8_STAGE(PG8_SB(1, 1), cB + hstepB + kstep, voffB);
        PG8_WAIT_V(6); PG8_BAR;
    } else {
        PG8_STAGE(PG8_SB(0, 0), cB, voffB); PG8_STAGE(PG8_SA(0, 0), cA, voffA); PG8_STAGE(PG8_SB(0, 1), cB + hstepB, voffB); PG8_STAGE(PG8_SA(0, 1), cA + hstepA, voffA);
        if (wr == 1) PG8_BAR;
        PG8_WAIT_V(4); PG8_BAR;
        PG8_STAGE(PG8_SB(1, 0), cB + kstep, voffB); PG8_STAGE(PG8_SA(1, 0), cA + kstep, voffA); PG8_STAGE(PG8_SB(1, 1), cB + hstepB + kstep, voffB);
        PG8_WAIT_V(6); PG8_BAR;
    }
    for (;;) {
        const bool has_next = S.next(ui + 1, nxt);
        const char* nA = has_next ? (const char*)g.A + (size_t)nxt.pm * tstepA + (size_t)nxt.pn * apn : cA; const char* nB = has_next ? (const char*)g.Bt + (size_t)nxt.pn * tstepB : cB;
        for (int t = 0; t < nt; t += 2) {
            const bool last = (t == nt - 2);
            const char* a1 = cA + (size_t)(t + 1) * kstep;
            const char* a2 = last ? nA : cA + (size_t)(t + 2) * kstep; const char* b2 = last ? nB : cB + (size_t)(t + 2) * kstep;
            const char* a3 = a2 + kstep; const char* b3 = b2 + kstep;
            if (last && has_next) S.a_ready(nxt);
            if constexpr (SP2) {
            PG8_LDB(B0, 0, 0); PG8_LDB(B1, 0, 1); PG8_SCHED; PG8_LDA(At, 0, 0); PG8_STAGE(PG8_SA(1, 1), a1 + hstepA, voffA);
            PG8_WAIT_V(8); PG8_WAIT_L(0); PG8_BAR; PG8_MMA(0, 0, At, B0); PG8_MMA(0, 1, At, B1); PG8_BAR; PG8_SCHED;
            PG8_LDA(At, 0, 1); PG8_STAGE(PG8_SB(0, 0), b2, voffB); PG8_STAGE(PG8_SB(0, 1), b2 + hstepB, voffB); PG8_STAGE(PG8_SA(0, 0), a2, voffA);
            PG8_WAIT_V(8); PG8_WAIT_L(0); PG8_BAR; PG8_MMA(1, 0, At, B0); PG8_MMA(1, 1, At, B1); PG8_BAR; PG8_SCHED;
            PG8_LDB(B0, 1, 0); PG8_LDB(B1, 1, 1); PG8_SCHED; PG8_LDA(At, 1, 0); PG8_STAGE(PG8_SA(0, 1), a2 + hstepA, voffA);
            PG8_WAIT_V(8); PG8_WAIT_L(0); PG8_BAR; PG8_MMA(0, 0, At, B0); PG8_MMA(0, 1, At, B1); PG8_BAR; PG8_SCHED;
            PG8_LDA(At, 1, 1); PG8_STAGE(PG8_SB(1, 0), b3, voffB); PG8_STAGE(PG8_SB(1, 1), b3 + hstepB, voffB); PG8_STAGE(PG8_SA(1, 0), a3, voffA);
            PG8_WAIT_V(8); PG8_WAIT_L(0); PG8_BAR; PG8_MMA(1, 0, At, B0); PG8_MMA(1, 1, At, B1); PG8_BAR; PG8_SCHED;
            } else {
            PG8_LDB(B0, 0, 0); PG8_SCHED; PG8_LDA(At, 0, 0); PG8_STAGE(PG8_SA(1, 1), a1 + hstepA, voffA);
            PG8_WAIT_L(8); PG8_BAR; PG8_WAIT_L(0); PG8_MMA(0, 0, At, B0); PG8_BAR; PG8_SCHED;
            PG8_LDB(B1, 0, 1); PG8_STAGE(PG8_SB(0, 0), b2, voffB);
            PG8_BAR; PG8_WAIT_L(0); PG8_MMA(0, 1, At, B1); PG8_BAR;
            PG8_LDA(At, 0, 1); PG8_STAGE(PG8_SA(0, 0), a2, voffA);
            PG8_BAR; PG8_WAIT_L(0); PG8_MMA(1, 0, At, B0); PG8_BAR; PG8_SCHED;
            PG8_STAGE(PG8_SB(0, 1), b2 + hstepB, voffB);
            PG8_WAIT_V(6); PG8_BAR; PG8_MMA(1, 1, At, B1); PG8_BAR;
            PG8_LDB(B0, 1, 0); PG8_SCHED; PG8_LDA(At, 1, 0); PG8_STAGE(PG8_SA(0, 1), a2 + hstepA, voffA);
            PG8_WAIT_L(8); PG8_BAR; PG8_WAIT_L(0); PG8_MMA(0, 0, At, B0); PG8_BAR; PG8_SCHED;
            PG8_LDB(B1, 1, 1); PG8_STAGE(PG8_SB(1, 0), b3, voffB);
            PG8_BAR; PG8_WAIT_L(0); PG8_MMA(0, 1, At, B1); PG8_BAR;
            PG8_LDA(At, 1, 1); PG8_STAGE(PG8_SA(1, 0), a3, voffA);
            PG8_BAR; PG8_WAIT_L(0); PG8_MMA(1, 0, At, B0); PG8_BAR; PG8_SCHED;
            PG8_STAGE(PG8_SB(1, 1), b3 + hstepB, voffB);
            PG8_WAIT_V(6); PG8_BAR; PG8_MMA(1, 1, At, B1); PG8_BAR;
            }
        }
        if constexpr (ALIGN_EPI) { if (wr == 0) PG8_BAR; }
        cur.boff1 = HALF;
        if (E.mode == 0 && cur.pn >= E.zpn0) {
            cur.boff1 = 0;
#pragma unroll
            for (int a = 0; a < 2; ++a)
#pragma unroll
                for (int m = 0; m < 4; ++m)
#pragma unroll
                    for (int n = 0; n < 2; ++n) { acc[a][0][m][n] = acc[a][0][m][n] * acc[a][1][m][n]; }
        }
        if constexpr (!Epi::AFTER_DRAIN) { E(acc, cur, wr, wc, fr, fq); S.done(cur, ui); }
        if (!has_next) break;
#pragma unroll
        for (int a = 0; a < 2; ++a)
#pragma unroll
            for (int b = 0; b < 2; ++b)
#pragma unroll
                for (int m = 0; m < 4; ++m)
#pragma unroll
                    for (int n = 0; n < 2; ++n) acc[a][b][m][n] = (f32x4){0.f, 0.f, 0.f, 0.f};
        cur = nxt; cA = nA; cB = nB; ++ui;
        if constexpr (ALIGN_EPI) { if (wr == 1) PG8_BAR; }
    }
    PG8_WAIT_V(0);
    if constexpr (!ALIGN_EPI) { if (wr == 0) PG8_BAR; }
    PG8_BAR;
#undef PG8_SA
#undef PG8_SB
#undef PG8_STAGE
#undef PG8_LDA
#undef PG8_LDB
#undef PG8_MMA
#undef PG8_WAIT_V
#undef PG8_WAIT_L
#undef PG8_BAR
#undef PG8_SCHED
}
}

#ifndef PG8_SP2
#define PG8_SP2 true
#endif
#ifndef PG8_ALIGN
#define PG8_ALIGN true
#endif

#define LAS __attribute__((address_space(3)))
typedef unsigned short bf16;
typedef unsigned v4u __attribute__((ext_vector_type(4)));
typedef unsigned v2u __attribute__((ext_vector_type(2)));
typedef float f32x4 __attribute__((ext_vector_type(4)));
#define LDS_WAIT() asm volatile("s_waitcnt lgkmcnt(0)" ::: "memory")
__device__ __forceinline__ unsigned pk2(float lo, float hi) { return pg8::cvt_pk_bf16(lo, hi); }
__device__ __forceinline__ float wave_sum(float v) {
#pragma unroll
    for (int o = 1; o < 64; o <<= 1) v += __shfl_xor(v, o);
    return v;
}
struct F8 { f32x4 a, b; };
__device__ __forceinline__ float bflo(unsigned u) { return __uint_as_float(u << 16); }
__device__ __forceinline__ float bfhi(unsigned u) { return __uint_as_float(u & 0xffff0000u); }
__device__ __forceinline__ F8 ld_bf8(const bf16* p) { const v4u w = *(const v4u*)p; F8 r; r.a = (f32x4){bflo(w.x), bfhi(w.x), bflo(w.y), bfhi(w.y)}; r.b = (f32x4){bflo(w.z), bfhi(w.z), bflo(w.w), bfhi(w.w)}; return r; }
__device__ __forceinline__ F8 ld_f8(const float* p) { F8 r; r.a = *(const f32x4*)p; r.b = *(const f32x4*)(p + 4); return r; }
__device__ __forceinline__ void st_bf8(bf16* p, const F8& v) { v4u w; w.x = pk2(v.a.x, v.a.y); w.y = pk2(v.a.z, v.a.w); w.z = pk2(v.b.x, v.b.y); w.w = pk2(v.b.z, v.b.w); *(v4u*)p = w; }
__device__ __forceinline__ void st_f8(float* p, const F8& v) { *(f32x4*)p = v.a; *(f32x4*)(p + 4) = v.b; }

__device__ __forceinline__ void p0_transpose_item(const float* W, int K, int N, bf16* WT, int row_off, LAS float* scr, int item, int lane, bool zperm = false, const float* kscale = nullptr, const float* nscale = nullptr) {
    const int nblk = N / 32, kb = item / nblk, nb = item % nblk, k0 = 64 * kb, n0 = 32 * nb;
    const int ns = (zperm && n0 >= 2 * PW) ? ((((n0 & 255) < 128) ? 2 * PW : 2 * PW + CW - 128) + 128 * ((n0 >> 8) - 8) + (n0 & 255)) : n0;
    const int l7 = lane & 7, l8 = lane >> 3;
    f32x4 v[8];
#pragma unroll
    for (int i = 0; i < 8; ++i) v[i] = __builtin_nontemporal_load((const f32x4*)(W + (size_t)(k0 + l8 + 8 * i) * N + ns + 4 * l7));
    if (kscale) {
#pragma unroll
        for (int i = 0; i < 8; ++i) v[i] = v[i] * kscale[k0 + l8 + 8 * i];
    }
    if (nscale) { const f32x4 sn = *(const f32x4*)(nscale + n0 + 4 * l7);
#pragma unroll
        for (int i = 0; i < 8; ++i) v[i] = v[i] * sn;
    }
#pragma unroll
    for (int i = 0; i < 8; ++i) { LAS float* d = scr + (l8 + 8 * i) * 33 + 4 * l7; d[0] = v[i].x; d[1] = v[i].y; d[2] = v[i].z; d[3] = v[i].w; }
    LDS_WAIT(); asm volatile("" ::: "memory");
    const int c = lane & 7;
#pragma unroll
    for (int j = 0; j < 4; ++j) { const int n = (lane >> 3) + 8 * j; const LAS float* s = scr + (8 * c) * 33 + n;
        v4u o; o.x = pk2(s[0 * 33], s[1 * 33]); o.y = pk2(s[2 * 33], s[3 * 33]); o.z = pk2(s[4 * 33], s[5 * 33]); o.w = pk2(s[6 * 33], s[7 * 33]);
        *(v4u*)(WT + (size_t)(row_off + n0 + n) * K + k0 + 8 * c) = o; }
    LDS_WAIT(); asm volatile("" ::: "memory");
}
__device__ __forceinline__ void rms_rows2_bf16(const float* x0, const float* x1, bool has1, const float* g, bf16* o0, bf16* o1, int lane) {
    const f32x4* xr0 = (const f32x4*)x0 + lane; const f32x4* xr1 = (const f32x4*)x1 + lane;
    f32x4 v[8], w[8]; float s0 = 0.f, s1 = 0.f;
#pragma unroll
    for (int j = 0; j < 8; ++j) v[j] = __builtin_nontemporal_load(xr0 + 64 * j);
    if (has1) {
#pragma unroll
        for (int j = 0; j < 8; ++j) w[j] = __builtin_nontemporal_load(xr1 + 64 * j);
    } else {
#pragma unroll
        for (int j = 0; j < 8; ++j) w[j] = (f32x4){0.f, 0.f, 0.f, 0.f};
    }
#pragma unroll
    for (int j = 0; j < 8; ++j) { s0 += (v[j].x * v[j].x + v[j].y * v[j].y) + (v[j].z * v[j].z + v[j].w * v[j].w); s1 += (w[j].x * w[j].x + w[j].y * w[j].y) + (w[j].z * w[j].z + w[j].w * w[j].w); }
    const float r0 = 1.f / sqrtf(wave_sum(s0) * (1.f / D) + EPS), r1 = 1.f / sqrtf(wave_sum(s1) * (1.f / D) + EPS);
    const f32x4* gr = (const f32x4*)g + lane;
    v2u* p0 = (v2u*)o0 + lane; v2u* p1 = (v2u*)o1 + lane;
#pragma unroll
    for (int j = 0; j < 8; ++j) { const f32x4 gv = gr[64 * j]; const f32x4 a = v[j] * r0 * gv; v2u q; q.x = pk2(a.x, a.y); q.y = pk2(a.z, a.w); p0[64 * j] = q;
        if (has1) { const f32x4 b = w[j] * r1 * gv; v2u q1; q1.x = pk2(b.x, b.y); q1.y = pk2(b.z, b.w); p1[64 * j] = q1; } }
}
__device__ __forceinline__ void rms_rows2_f32_inplace(float* x0, float* x1, bool has1, const float* g, int lane) {
    f32x4* xr0 = (f32x4*)x0 + lane; f32x4* xr1 = (f32x4*)x1 + lane;
    f32x4 v[8], w[8]; float s0 = 0.f, s1 = 0.f;
#pragma unroll
    for (int j = 0; j < 8; ++j) v[j] = xr0[64 * j];
    if (has1) {
#pragma unroll
        for (int j = 0; j < 8; ++j) w[j] = xr1[64 * j];
    } else {
#pragma unroll
        for (int j = 0; j < 8; ++j) w[j] = (f32x4){0.f, 0.f, 0.f, 0.f};
    }
#pragma unroll
    for (int j = 0; j < 8; ++j) { s0 += (v[j].x * v[j].x + v[j].y * v[j].y) + (v[j].z * v[j].z + v[j].w * v[j].w); s1 += (w[j].x * w[j].x + w[j].y * w[j].y) + (w[j].z * w[j].z + w[j].w * w[j].w); }
    const float r0 = 1.f / sqrtf(wave_sum(s0) * (1.f / D) + EPS), r1 = 1.f / sqrtf(wave_sum(s1) * (1.f / D) + EPS);
    const f32x4* gr = (const f32x4*)g + lane;
#pragma unroll
    for (int j = 0; j < 8; ++j) { const f32x4 gv = gr[64 * j]; xr0[64 * j] = v[j] * r0 * gv; if (has1) xr1[64 * j] = w[j] * r1 * gv; }
}

__device__ __forceinline__ F8 cvt_bf8(const v4u w) { F8 r; r.a = (f32x4){bflo(w.x), bfhi(w.x), bflo(w.y), bfhi(w.y)}; r.b = (f32x4){bflo(w.z), bfhi(w.z), bflo(w.w), bfhi(w.w)}; return r; }
__device__ __forceinline__ void rms_rows2_bf16_to_f32(const bf16* h0, const bf16* h1, bool has1, const float* g, float* o0, float* o1, int lane) {
    const v4u* r0 = (const v4u*)h0 + lane; const v4u* r1 = (const v4u*)h1 + lane;
    v4u a[4], b[4];
#pragma unroll
    for (int j = 0; j < 4; ++j) a[j] = __builtin_nontemporal_load(r0 + 64 * j);
    if (has1) {
#pragma unroll
        for (int j = 0; j < 4; ++j) b[j] = __builtin_nontemporal_load(r1 + 64 * j);
    } else {
#pragma unroll
        for (int j = 0; j < 4; ++j) b[j] = (v4u){0u, 0u, 0u, 0u};
    }
    F8 v[4], w[4]; float s0 = 0.f, s1 = 0.f;
#pragma unroll
    for (int j = 0; j < 4; ++j) { v[j] = cvt_bf8(a[j]); w[j] = cvt_bf8(b[j]);
        const f32x4 q0 = v[j].a * v[j].a + v[j].b * v[j].b, q1 = w[j].a * w[j].a + w[j].b * w[j].b; s0 += (q0.x + q0.y) + (q0.z + q0.w); s1 += (q1.x + q1.y) + (q1.z + q1.w); }
    const float i0 = 1.f / sqrtf(wave_sum(s0) * (1.f / D) + EPS), i1 = 1.f / sqrtf(wave_sum(s1) * (1.f / D) + EPS);
#pragma unroll
    for (int j = 0; j < 4; ++j) { const f32x4 ga = *((const f32x4*)g + 2 * (lane + 64 * j)), gb = *((const f32x4*)g + 2 * (lane + 64 * j) + 1);
        f32x4* p0 = (f32x4*)o0 + 2 * (lane + 64 * j); __builtin_nontemporal_store(v[j].a * i0 * ga, p0); __builtin_nontemporal_store(v[j].b * i0 * gb, p0 + 1);
        if (has1) { f32x4* p1 = (f32x4*)o1 + 2 * (lane + 64 * j); __builtin_nontemporal_store(w[j].a * i1 * ga, p1); __builtin_nontemporal_store(w[j].b * i1 * gb, p1 + 1); } }
}

__device__ __forceinline__ void mixer_item_generic(int j, int c, const bf16* PROJ, const float* cache_pool, const float* cache_conv, const float* conv_w, bf16* DMAT, bf16* MIX, float* out) {
    const bool samp = j >= MPO; int b, t; size_t prow;
    if (!samp) { b = j >> 11; t = j & 2047; prow = (size_t)b * LP + NMETA + t; }
    else { const int s = j - MPO; b = s >> 5; t = s & 31; prow = (size_t)MP + s; }
    if (c < 128) {
        const int ch = c * 8, w = 2 << (c >> 5);
        const bf16* base = PROJ + prow * LDP + ch;
        const F8 u = ld_bf8(base); F8 sum = u;
        for (int k = 1; k < w; ++k) {
            F8 e;
            if (!samp || t - k >= 0) e = ld_bf8(base - (size_t)k * LDP);
            else e = ld_f8(cache_pool + ((size_t)b * 15 + (15 + t - k)) * PW + ch);
            sum.a += e.a; sum.b += e.b;
        }
        const float inv = 1.f / (float)w;
        F8 d; d.a = sum.a * inv - u.a; d.b = sum.b * inv - u.b;
        st_bf8(DMAT + (size_t)j * PW + ch, d);
        if (!samp) { if (t >= SEQ - 15) st_f8(out + O_SPP + ((size_t)b * 15 + (t - (SEQ - 15))) * PW + ch, u); }
        else { if (t >= SL - 15) st_f8(out + O_SPS + ((size_t)b * 15 + (t - (SL - 15))) * PW + ch, u); }
    } else {
        const int ch = (c - 128) * 8;
        const bf16* base = PROJ + prow * LDP + ch;
        const F8 bg = ld_bf8(base + PW), z0 = ld_bf8(base + ZOFF(ch));
        F8 z1, z2;
        if (!samp || t >= 1) z1 = ld_bf8(base - LDP + ZOFF(ch)); else z1 = ld_f8(cache_conv + ((size_t)b * 2 + 1) * CW + ch);
        if (!samp || t >= 2) z2 = ld_bf8(base - 2 * (size_t)LDP + ZOFF(ch)); else z2 = ld_f8(cache_conv + ((size_t)b * 2 + t) * CW + ch);
        const F8 w0 = ld_f8(conv_w + ch), w1 = ld_f8(conv_w + CW + ch), w2 = ld_f8(conv_w + 2 * CW + ch);
        F8 y; y.a = bg.a * (z2.a * w0.a + z1.a * w1.a + z0.a * w2.a); y.b = bg.b * (z2.b * w0.b + z1.b * w1.b + z0.b * w2.b);
        st_bf8(MIX + (size_t)j * D + PW + ch, y);
        if (!samp) { if (t >= SEQ - 2) st_f8(out + O_SCP + ((size_t)b * 2 + (t - (SEQ - 2))) * CW + ch, z0); }
        else { if (t >= SL - 2) st_f8(out + O_SCS + ((size_t)b * 2 + (t - (SL - 2))) * CW + ch, z0); }
    }
}
template <int W> __device__ __forceinline__ void pool_rows4_prompt(const bf16* PROJ, bf16* DMAT, float* out, int j0, int ch) {
    const int b = j0 >> 11, t0 = j0 & 2047;
    const bf16* base = PROJ + ((size_t)b * LP + NMETA + t0 + 3) * LDP + ch;
    v4u raw[W + 3];
#pragma unroll
    for (int k = 0; k < W + 3; ++k) raw[k] = *(const v4u*)(base - (size_t)k * LDP);
    F8 S = cvt_bf8(raw[3]);
#pragma unroll
    for (int k = 4; k < W + 3; ++k) { const F8 e = cvt_bf8(raw[k]); S.a += e.a; S.b += e.b; }
    const float inv = 1.f / (float)W;
#pragma unroll
    for (int i = 0; i < 4; ++i) {
        const F8 u = cvt_bf8(raw[3 - i]);
        if (i > 0) { const F8 o = cvt_bf8(raw[W + 3 - i]); S.a += u.a - o.a; S.b += u.b - o.b; }
        F8 d; d.a = S.a * inv - u.a; d.b = S.b * inv - u.b;
        st_bf8(DMAT + (size_t)(j0 + i) * PW + ch, d);
        if (t0 + i >= SEQ - 15) st_f8(out + O_SPP + ((size_t)b * 15 + (t0 + i - (SEQ - 15))) * PW + ch, u);
    }
}
__device__ __forceinline__ void conv_rows4_prompt(const bf16* PROJ, const float* conv_w, bf16* MIX, float* out, int j0, int ch) {
    const int b = j0 >> 11, t0 = j0 & 2047;
    const bf16* base = PROJ + ((size_t)b * LP + NMETA + t0) * LDP + ch;
    v4u rz[6], rb[4];
#pragma unroll
    for (int k = 0; k < 6; ++k) rz[k] = *(const v4u*)(base + (ptrdiff_t)(k - 2) * LDP + ZOFF(ch));
#pragma unroll
    for (int i = 0; i < 4; ++i) rb[i] = *(const v4u*)(base + (size_t)i * LDP + PW);
    const F8 w0 = ld_f8(conv_w + ch), w1 = ld_f8(conv_w + CW + ch), w2 = ld_f8(conv_w + 2 * CW + ch);
    F8 z[6];
#pragma unroll
    for (int k = 0; k < 6; ++k) z[k] = cvt_bf8(rz[k]);
#pragma unroll
    for (int i = 0; i < 4; ++i) {
        const F8 bg = cvt_bf8(rb[i]);
        F8 y; y.a = bg.a * (z[i].a * w0.a + z[i + 1].a * w1.a + z[i + 2].a * w2.a); y.b = bg.b * (z[i].b * w0.b + z[i + 1].b * w1.b + z[i + 2].b * w2.b);
        st_bf8(MIX + (size_t)(j0 + i) * D + PW + ch, y);
        if (t0 + i >= SEQ - 2) st_f8(out + O_SCP + ((size_t)b * 2 + (t0 + i - (SEQ - 2))) * CW + ch, z[i + 2]);
    }
}

#define XB_TMO      128
#define XB_XCNT(j)  (256  + 64 * (j))
#define XB_XSUB(j)  (1280 + 64 * (j))
#define XB_XGEN(j)  (2304 + 64 * (j))
#define XB_TOP      3328
#define XB_TOPGEN   3392
#define XCD_BAR_WORDS 3456
#define XB_SPIN_CAP (1u << 20)
__device__ __forceinline__ unsigned xb_ld(unsigned* p)              { return __hip_atomic_load(p, __ATOMIC_RELAXED, __HIP_MEMORY_SCOPE_AGENT); }
__device__ __forceinline__ unsigned xb_add(unsigned* p, unsigned v) { return __hip_atomic_fetch_add(p, v, __ATOMIC_RELAXED, __HIP_MEMORY_SCOPE_AGENT); }
__device__ __forceinline__ unsigned xb_xcc_id() { return (unsigned)__builtin_amdgcn_s_getreg((3 << 11) | 20) & 0xFu; }
#define XB_SPIN(cond, bar) do { unsigned _sp = 0; while (cond) { __builtin_amdgcn_s_sleep(1); \
    if ((++_sp & 255u) == 0u) { if (xb_ld(&(bar)[XB_TMO])) break; if (_sp > XB_SPIN_CAP) { atomicAdd(&(bar)[XB_TMO], 1u); break; } } } } while (0)
__device__ __forceinline__ void xcd_barrier_post(unsigned* bar) { if (threadIdx.x == 0) (void)xb_add(&bar[XB_XCNT(xb_xcc_id())], 1u); }
__device__ __forceinline__ void xcd_barrier_complete(unsigned* bar, unsigned x, unsigned& nloc, unsigned& nx) {
    const unsigned G = gridDim.x * gridDim.y * gridDim.z;
    unsigned sum, cnt, mine, sp = 0u;
    for (;;) {
        sum = 0u; cnt = 0u; mine = 0u;
#pragma unroll
        for (unsigned j = 0; j < 16; ++j) { const unsigned c = xb_ld(&bar[XB_XCNT(j)]); sum += c; cnt += (c > 0u) ? 1u : 0u; mine = (j == x) ? c : mine; }
        if (sum == G) break;
        __builtin_amdgcn_s_sleep(1);
        if ((++sp & 255u) == 0u) { if (xb_ld(&bar[XB_TMO])) break; if (sp > XB_SPIN_CAP) { atomicAdd(&bar[XB_TMO], 1u); break; } }
    }
    nloc = mine > 0u ? mine : 1u; nx = cnt > 0u ? cnt : 1u;
}
__device__ __forceinline__ void xcd_barrier(unsigned* bar, volatile LAS unsigned* st) {
    asm volatile("s_waitcnt vmcnt(0)" ::: "memory");
    __syncthreads();
    if (threadIdx.x == 0) {
        const unsigned x = xb_xcc_id();
        __builtin_amdgcn_s_waitcnt(0);
        unsigned nloc = st[0], nx = st[1];
        if (nloc == 0u) { xcd_barrier_complete(bar, x, nloc, nx); st[0] = nloc; st[1] = nx; }
        const unsigned old = xb_add(&bar[XB_XSUB(x)], 1u);
        const unsigned gen = old / nloc;
        if (old + 1u == (gen + 1u) * nloc) {
            __builtin_amdgcn_fence(__ATOMIC_RELEASE, "agent");
            asm volatile("s_waitcnt vmcnt(0)" ::: "memory");
            const unsigned og = xb_add(&bar[XB_TOP], 1u);
            const unsigned tg = og / nx;
            if (og + 1u == (tg + 1u) * nx) xb_add(&bar[XB_TOPGEN], 1u);
            else XB_SPIN(xb_ld(&bar[XB_TOPGEN]) == tg, bar);
            __builtin_amdgcn_fence(__ATOMIC_ACQUIRE, "agent");
            xb_add(&bar[XB_XGEN(x)], 1u);
            asm volatile("s_waitcnt vmcnt(0)" ::: "memory");
        } else {
            XB_SPIN(xb_ld(&bar[XB_XGEN(x)]) == gen, bar);
            __builtin_amdgcn_fence(__ATOMIC_ACQUIRE, "agent");
            asm volatile("s_waitcnt vmcnt(0)" ::: "memory");
        }
    }
    __syncthreads();
}

struct Args { const float* in[15]; float* out; unsigned char* ws; };

__global__ void __launch_bounds__(512, 2) mega_fwd(Args args) {
    extern __shared__ __attribute__((aligned(16))) unsigned char lds_raw[];
    cg::grid_group grid = cg::this_grid();
    LAS unsigned char* lds = (LAS unsigned char*)lds_raw;
    const int G = gridDim.x, bx = blockIdx.x, NGW = G * 8;
    if (threadIdx.x < 2) ((volatile LAS unsigned*)(lds + 131072 + 64))[threadIdx.x] = 0u;
    __syncthreads();
    xcd_barrier_post((unsigned*)(args.ws + WS_CTL));
#define GRID_BAR() xcd_barrier((unsigned*)(args.ws + WS_CTL), (volatile LAS unsigned*)(lds + 131072 + 64))
    unsigned char* ws = args.ws;
    const float* xp = args.in[0]; const float* xs = args.in[1]; const float* cache_pool = args.in[2]; const float* cache_conv = args.in[3];
    const float* meta = args.in[4]; const float* norm1_g = args.in[5]; const float* w_in = args.in[6]; const float* w_pool = args.in[7];
    const float* pool_scale = args.in[8]; const float* conv_w = args.in[9]; const float* w_out = args.in[10]; const float* norm2_g = args.in[11];
    const float* w_up = args.in[12]; const float* w_down = args.in[13]; const float* final_g = args.in[14];
    float* out = args.out;
    bf16* WIN = (bf16*)(ws + WS_WIN); bf16* WOUT = (bf16*)(ws + WS_WOUT); bf16* WUP = (bf16*)(ws + WS_WUP); bf16* WDOWN = (bf16*)(ws + WS_WDOWN); bf16* WPOOL = (bf16*)(ws + WS_WPOOL);
    bf16* HN = (bf16*)(ws + WS_HN); bf16* PROJ = (bf16*)(ws + WS_PROJ); bf16* DMAT = (bf16*)(ws + WS_DMAT); bf16* MIX = (bf16*)(ws + WS_MIX); bf16* ACT = (bf16*)(ws + WS_BIG);

    {
        int tid0 = threadIdx.x; asm volatile("" : "+v"(tid0)); const int lane = tid0 & 63, wave = __builtin_amdgcn_readfirstlane(tid0 >> 6), gw = bx * 8 + wave;
        LAS float* scr = (LAS float*)(lds + wave * 16384);
        constexpr int I_IN = (D / 64) * (INW / 32), I_OUT = (D / 64) * (D / 32), I_PG = (PGC / 64) * (PGC / 32);
        constexpr int NITEMS = I_IN + I_OUT + 4 * I_PG;
        for (int i = bx * 512 + tid0; i < M2; i += G * 512) ((float*)(ws + WS_SSQ))[i] = 0.f;
        for (int it = gw; it < NITEMS; it += NGW) {
            int r = it;
            if (r < I_IN) { p0_transpose_item(w_in, D, INW, WIN, 0, scr, r, lane, true); continue; } r -= I_IN;
            if (r < I_OUT) { p0_transpose_item(w_out, D, D, WOUT, 0, scr, r, lane); continue; } r -= I_OUT;
            const int gq = r / I_PG; r -= gq * I_PG;
            p0_transpose_item(w_pool + (size_t)gq * PGC * PGC, PGC, PGC, WPOOL, gq * PGC, scr, r, lane, false, nullptr, pool_scale + gq * PGC);
        }
        for (int p = gw; p < M1; p += 2 * NGW) {
            const int p1 = p + NGW; const bool has1 = p1 < M1; const int pc = has1 ? p1 : p;
            const float* xr0; const float* xr1;
            if (p < MP) { const int b = p / LP, pos = p - b * LP; xr0 = pos < NMETA ? meta + (size_t)pos * D : xp + ((size_t)b * SEQ + (pos - NMETA)) * D; }
            else xr0 = xs + (size_t)(p - MP) * D;
            if (pc < MP) { const int b = pc / LP, pos = pc - b * LP; xr1 = pos < NMETA ? meta + (size_t)pos * D : xp + ((size_t)b * SEQ + (pos - NMETA)) * D; }
            else xr1 = xs + (size_t)(pc - MP) * D;
            rms_rows2_bf16(xr0, xr1, has1, norm1_g, HN + (size_t)p * D, HN + (size_t)pc * D, lane);
        }
    }
    GRID_BAR();
    if (out == nullptr) grid.sync();

    const bool ov = (G == 256);
    unsigned* sig2 = (unsigned*)(ws + WS_CTL) + 6144;
    unsigned* sigT = (unsigned*)(ws + WS_CTL) + 7680;
    for (int st = 0; st < 6; ++st) {
        if (st == 4 && !ov) continue;
        const int gi = st < 4 ? st : st - 1;
        if (gi == 1) {
            {
                int tid2 = threadIdx.x; asm volatile("" : "+v"(tid2));
                const int lane = tid2 & 63, gw = bx * 8 + __builtin_amdgcn_readfirstlane(tid2 >> 6), half = lane >> 5, l31 = lane & 31;
                const int cb = gw & 7, vb = ((G & 7) == 0) ? (bx & 7) * (G >> 3) + (bx >> 3) : bx;
                for (int q = vb; q < MPO / 8; q += G) {
                    const int j0 = 8 * q + 4 * half;
                    if (cb == 0) pool_rows4_prompt<2>(PROJ, DMAT, out, j0, l31 * 8);
                    else if (cb == 1) pool_rows4_prompt<4>(PROJ, DMAT, out, j0, (32 + l31) * 8);
                    else if (cb == 2) pool_rows4_prompt<8>(PROJ, DMAT, out, j0, (64 + l31) * 8);
                    else if (cb == 3) pool_rows4_prompt<16>(PROJ, DMAT, out, j0, (96 + l31) * 8);
                    else conv_rows4_prompt(PROJ, conv_w, MIX, out, j0, ((cb - 4) * 32 + l31) * 8);
                }
                for (int rp = vb; rp < MS / 2; rp += G) mixer_item_generic(MPO + 2 * rp + half, cb * 32 + l31, PROJ, cache_pool, cache_conv, conv_w, DMAT, MIX, out);
            }

            GRID_BAR();
        }
        pg8::Gemm g; pg8::EpiAny E;
        E.scale = pool_scale; E.xp = xp; E.xs = xs; E.out = out; E.O = PROJ; E.ldc = LDP; E.mode = 0; E.ssq = (float*)(ws + WS_SSQ); E.zpn0 = (gi == 0) ? 2 * PW / 256 : (1 << 30);
        switch (gi) {
        case 0:  g = pg8::Gemm{HN, WIN, M1, INW, D, D, D, 0}; break;
        case 1:  g = pg8::Gemm{DMAT, WPOOL, M2, PW, PGC, PW, PGC, PGC}; E.mode = 0; E.O = MIX; E.ldc = D; break;
        case 2:  g = pg8::Gemm{MIX, WOUT, M2, D, D, D, D, 0}; E.mode = 4; E.O = HN; E.ldc = D; break;
        case 3:  g = pg8::Gemm{HN, WUP, M2, FF, D, D, D, 0}; E.mode = 1; E.O = ACT; E.ldc = FF; break;
        default: g = pg8::Gemm{ACT, WDOWN, M2, D, FF, FF, FF, 0}; E.mode = 5; E.O = HN; E.ldc = D; break;
        }
        const bool tail4 = (gi == 4 && G == 256), tail2 = (gi == 2 && ov);
        unsigned* sig = (unsigned*)(ws + WS_CTL) + 4096;
        pg8::StaticOrder S;
        volatile LAS unsigned* bst = (volatile LAS unsigned*)(lds + 131072 + 64);
        const int wgm = (gi == 0 || gi == 2) ? 8 : ((gi == 3) ? WGM_A : WGM_B);
        if (tail4) S.init(MPO, g.N, G, bx, wgm, (M2 - MPO) / 256, sig, 3, bst[0]);
        else if (tail2) S.init(MPO, g.N, G, bx, wgm, (M2 - MPO) / 256, sig2, 3, bst[0]);
        else if (st == 3 && ov) S.init(MPO, g.N, G, bx, wgm);
        else if (st == 4) {
            if (bx >= 128 && threadIdx.x == 0) { unsigned sp = 0;
                while (__hip_atomic_load(sigT, __ATOMIC_RELAXED, __HIP_MEMORY_SCOPE_AGENT) < 32u) { __builtin_amdgcn_s_sleep(2); if (++sp > (1u << 22)) break; }
                __builtin_amdgcn_fence(__ATOMIC_ACQUIRE, "agent"); asm volatile("s_waitcnt vmcnt(0)" ::: "memory"); }
            __syncthreads();
            S.init(MPO, g.N, G, (bx + 128) & 255, wgm, (M2 - MPO) / 256, nullptr, -1, 0, (MPO / 256) * (FF / 256) / 256);
        }
        else S.init(g.M, g.N, G, bx, wgm);
        pg8::gemm_phase<pg8::EpiAny, pg8::StaticOrder, PG8_ALIGN, PG8_SP2>(lds, g, S, E);
        if (gi == 0) {
            constexpr int I_UP = (D / 64) * (FF / 32), I_DOWN = (FF / 64) * (D / 32);
            const int rem = ((M1 / 256) * (INW / 256)) % G, n_idle = rem ? G - rem : G, ic = rem ? bx - rem : bx;
            if (ic >= 0) {
                int tidb = threadIdx.x; asm volatile("" : "+v"(tidb)); const int lane = tidb & 63, wave = __builtin_amdgcn_readfirstlane(tidb >> 6);
                LAS float* scr = (LAS float*)(lds + wave * 16384);
                for (int it = ic * 8 + wave; it < I_UP + I_DOWN; it += n_idle * 8) {
                    if (it < I_UP) p0_transpose_item(w_up, D, FF, WUP, 0, scr, it, lane, false, norm2_g);
                    else p0_transpose_item(w_down, FF, D, WDOWN, 0, scr, it - I_UP, lane);
                }
            }
        }
        if (tail4 && bx >= S.ntail) {
            if (threadIdx.x == 0) {
                unsigned sp = 0; const unsigned want = bst[1];
                while (__hip_atomic_load(sig, __ATOMIC_RELAXED, __HIP_MEMORY_SCOPE_AGENT) < want) { __builtin_amdgcn_s_sleep(2); if (++sp > (1u << 22)) break; }
                __builtin_amdgcn_fence(__ATOMIC_ACQUIRE, "agent");
                asm volatile("s_waitcnt vmcnt(0)" ::: "memory");
            }
            __syncthreads();
            int tidc = threadIdx.x; asm volatile("" : "+v"(tidc)); const int lane = tidc & 63, iw = (bx - S.ntail) * 8 + __builtin_amdgcn_readfirstlane(tidc >> 6), nw = (G - S.ntail) * 8;
            for (int p = iw; p < MPO; p += 2 * nw) { const int p1 = p + nw; const bool has1 = p1 < MPO; const int pc = has1 ? p1 : p;
                rms_rows2_bf16_to_f32(HN + (size_t)p * D, HN + (size_t)pc * D, has1, final_g, out + (size_t)p * D, out + (size_t)pc * D, lane); }
        }
        if (tail2) {
            if (bx < S.ntail) { asm volatile("s_waitcnt vmcnt(0)" ::: "memory"); __syncthreads();
                if (threadIdx.x == 0) { __builtin_amdgcn_fence(__ATOMIC_RELEASE, "agent"); asm volatile("s_waitcnt vmcnt(0)" ::: "memory"); __hip_atomic_fetch_add(sigT, 1u, __ATOMIC_RELAXED, __HIP_MEMORY_SCOPE_AGENT); } }
            if (threadIdx.x == 0) { unsigned sp = 0; const unsigned want = bst[1];
                while (__hip_atomic_load(sig2, __ATOMIC_RELAXED, __HIP_MEMORY_SCOPE_AGENT) < want) { __builtin_amdgcn_s_sleep(2); if (++sp > (1u << 22)) break; }
                __builtin_amdgcn_fence(__ATOMIC_ACQUIRE, "agent"); asm volatile("s_waitcnt vmcnt(0)" ::: "memory"); }
            __syncthreads();
        }
        else if (st == 3 && ov) { }
        else GRID_BAR();
    }

    int tid8 = threadIdx.x; asm volatile("" : "+v"(tid8)); const int lane = tid8 & 63, gw = bx * 8 + __builtin_amdgcn_readfirstlane(tid8 >> 6);
    for (int p = (G == 256 ? MPO : 0) + gw; p < M2; p += 2 * NGW) { const int p1 = p + NGW; const bool has1 = p1 < M2; const int pc = has1 ? p1 : p;
        rms_rows2_bf16_to_f32(HN + (size_t)p * D, HN + (size_t)pc * D, has1, final_g, out + (size_t)p * D, out + (size_t)pc * D, lane); }
}

extern "C" void kernel_launch(void* const* d_in, const int* in_sizes, int n_in, void* d_out, int out_size, void* d_ws, size_t ws_size, hipStream_t stream) {
    static int grid = 0;
    if (grid == 0) {
        if (n_in != 15 || ws_size < WS_END) { fprintf(stderr, "kernel_launch: unexpected n_in %d / ws_size %zu (need %zu)\n", n_in, ws_size, (size_t)WS_END); grid = -1; return; }
        int dev = 0, cus = 0, per_cu = 0;
        if (hipGetDevice(&dev) != hipSuccess || hipDeviceGetAttribute(&cus, hipDeviceAttributeMultiprocessorCount, dev) != hipSuccess) { grid = -1; return; }
        if (hipFuncSetAttribute((const void*)mega_fwd, hipFuncAttributeMaxDynamicSharedMemorySize, LDS_BYTES) != hipSuccess) { fprintf(stderr, "kernel_launch: hipFuncSetAttribute failed\n"); grid = -1; return; }
        if (hipOccupancyMaxActiveBlocksPerMultiprocessor(&per_cu, (const void*)mega_fwd, 512, LDS_BYTES) != hipSuccess || per_cu < 1) { fprintf(stderr, "kernel_launch: occupancy query says %d\n", per_cu); per_cu = 1; }
        (void)hipGetLastError();
        grid = cus * per_cu;
    }
    if (grid < 0) return;
    if (hipMemsetAsync((char*)d_ws + WS_CTL, 0, 65536, stream) != hipSuccess) { fprintf(stderr, "kernel_launch: memset failed\n"); return; }
    Args a{};
    for (int i = 0; i < 15; ++i) a.in[i] = (const float*)d_in[i];
    a.out = (float*)d_out; a.ws = (unsigned char*)d_ws;
    void* kargs[] = {&a};
    hipError_t e = hipLaunchCooperativeKernel((const void*)mega_fwd, dim3(grid), dim3(512), kargs, LDS_BYTES, stream);
    if (e != hipSuccess) fprintf(stderr, "kernel_launch: cooperative launch failed: %s (grid %d)\n", hipGetErrorString(e), grid);
}
```
